# Optimizing an MI355X kernel written in HIP

```python
import math
import jax, jax.numpy as jnp
from jax import lax
import numpy as np

D_MODEL = 4096
BATCH = 4
SEQ = 4096
DEPTH = 1

N_META = 16
D_FF = 11008
D_RGLRU = D_MODEL // 2
RG_HEADS = 8
RG_HEAD_DIM = D_RGLRU // RG_HEADS
CONV_WIDTH = 4
RG_C = 8.0
D_S5 = D_MODEL - D_RGLRU
S5_GROUP = 16
S5_GROUPS = D_S5 // S5_GROUP
S5_STATE = 64
DT_MIN = 0.001
DT_MAX = 0.1
D_MIX = D_RGLRU + D_S5
D_IN_PROJ = 2 * D_RGLRU + D_S5
EPS = 1e-6

kernel_name = "hymba_rglru_s5_macaron_layer"


def rmsnorm(x, g):
    xf = x.astype(jnp.float32)
    y = xf * lax.rsqrt(jnp.mean(xf * xf, axis=-1, keepdims=True) + EPS)
    return (y * g.astype(jnp.float32)).astype(x.dtype)


def swiglu(h, w_gate, w_up, w_down):
    return (jax.nn.silu(h @ w_gate) * (h @ w_up)) @ w_down


def rg_lru_mixer(u, gate, conv_w, conv_b, w_a, b_a, w_x, b_x, lam):
    bsz, t_len, _ = u.shape
    up = jnp.pad(u, ((0, 0), (CONV_WIDTH - 1, 0), (0, 0)))
    xc = conv_b + sum(up[:, k:k + t_len] * conv_w[k] for k in range(CONV_WIDTH))
    xh = xc.reshape(bsz, t_len, RG_HEADS, RG_HEAD_DIM)
    r = jax.nn.sigmoid(jnp.einsum('bthi,hij->bthj', xh, w_a) + b_a).reshape(bsz, t_len, D_RGLRU)
    i = jax.nn.sigmoid(jnp.einsum('bthi,hij->bthj', xh, w_x) + b_x).reshape(bsz, t_len, D_RGLRU)
    log_a = -RG_C * r.astype(jnp.float32) * jax.nn.softplus(-lam.astype(jnp.float32))
    a = jnp.exp(log_a)
    mult = jnp.sqrt(-jnp.expm1(2.0 * log_a))
    bx = mult * i.astype(jnp.float32) * xc.astype(jnp.float32)

    def step(h, ab):
        a_t, b_t = ab
        h = a_t * h + b_t
        return h, h

    _, hs = lax.scan(step, jnp.zeros((bsz, D_RGLRU), jnp.float32),
                     (jnp.swapaxes(a, 0, 1), jnp.swapaxes(bx, 0, 1)))
    h = jnp.swapaxes(hs, 0, 1)
    return (h * jax.nn.gelu(gate.astype(jnp.float32))).astype(u.dtype)


def s5_mixer(u, lam_re, lam_im, log_dt, b_re, b_im, c_re, c_im, d, glu_w, glu_b):
    bsz, t_len, _ = u.shape
    f32 = jnp.float32
    dt = jnp.exp(log_dt.astype(f32))[:, None]
    lam = lax.complex(lam_re.astype(f32), lam_im.astype(f32))
    lam_bar = jnp.exp(lam * dt)
    b = lax.complex(b_re.astype(f32), b_im.astype(f32))
    b_bar = ((lam_bar - 1.0) / lam)[..., None] * b
    ug = u.astype(f32).reshape(bsz, t_len, S5_GROUPS, S5_GROUP)
    bu = jnp.einsum('btgc,gnc->btgn', ug, b_bar)
    a_elems = jnp.broadcast_to(lam_bar[None, None], (1, t_len, S5_GROUPS, S5_STATE))

    def combine(e_i, e_j):
        a_i, b_i = e_i
        a_j, b_j = e_j
        return (a_j * a_i, a_j * b_i + b_j)

    _, states = lax.associative_scan(combine, (a_elems, bu), axis=1)
    c = lax.complex(c_re.astype(f32), c_im.astype(f32))
    y = jnp.einsum('btgn,gcn->btgc', states, c).real
    y = y + d.astype(f32).reshape(S5_GROUPS, S5_GROUP) * ug
    y = y.reshape(bsz, t_len, D_S5).astype(u.dtype)
    z = jax.nn.gelu(y)
    return z * jax.nn.sigmoid(z @ glu_w + glu_b)


def setup_inputs(seed: int = 0) -> dict:
    key = jax.random.key(seed)
    ks = jax.random.split(key, 40)
    f32 = jnp.float32
    nrm = lambda k, shape, s: jax.random.normal(k, shape, f32) * s
    L = DEPTH
    u = jax.random.uniform(ks[30], (L, D_RGLRU), f32, 0.9, 0.999)
    rg_lambda = jnp.log(u ** (1.0 / RG_C)) - jnp.log1p(-(u ** (1.0 / RG_C)))
    n_idx = jnp.arange(S5_STATE, dtype=f32)
    s5_lambda_re = -0.5 + nrm(ks[31], (L, S5_GROUPS, S5_STATE), 0.01)
    s5_lambda_im = math.pi * n_idx + nrm(ks[32], (L, S5_GROUPS, S5_STATE), 0.01)
    s5_log_dt = jax.random.uniform(ks[33], (L, S5_GROUPS), f32, math.log(DT_MIN), math.log(DT_MAX))
    return {
        "x": nrm(ks[0], (BATCH, SEQ, D_MODEL), 1.0),
        "meta_tokens": nrm(ks[1], (N_META, D_MODEL), 1.0),
        "ffn1_norm": 1.0 + nrm(ks[2], (L, D_MODEL), 0.02),
        "ffn1_w_gate": nrm(ks[3], (L, D_MODEL, D_FF), D_MODEL ** -0.5),
        "ffn1_w_up": nrm(ks[4], (L, D_MODEL, D_FF), D_MODEL ** -0.5),
        "ffn1_w_down": nrm(ks[5], (L, D_FF, D_MODEL), D_FF ** -0.5),
        "mix_norm": 1.0 + nrm(ks[6], (L, D_MODEL), 0.02),
        "w_in": nrm(ks[7], (L, D_MODEL, D_IN_PROJ), D_MODEL ** -0.5),
        "rg_conv_w": nrm(ks[8], (L, CONV_WIDTH, D_RGLRU), CONV_WIDTH ** -0.5),
        "rg_conv_b": nrm(ks[9], (L, D_RGLRU), 0.01),
        "rg_w_a": nrm(ks[10], (L, RG_HEADS, RG_HEAD_DIM, RG_HEAD_DIM), RG_HEAD_DIM ** -0.5),
        "rg_b_a": nrm(ks[11], (L, RG_HEADS, RG_HEAD_DIM), 0.01),
        "rg_w_x": nrm(ks[12], (L, RG_HEADS, RG_HEAD_DIM, RG_HEAD_DIM), RG_HEAD_DIM ** -0.5),
        "rg_b_x": nrm(ks[13], (L, RG_HEADS, RG_HEAD_DIM), 0.01),
        "rg_lambda": rg_lambda,
        "s5_lambda_re": s5_lambda_re,
        "s5_lambda_im": s5_lambda_im,
        "s5_log_dt": s5_log_dt,
        "s5_b_re": nrm(ks[14], (L, S5_GROUPS, S5_STATE, S5_GROUP), (2.0 * S5_GROUP) ** -0.5),
        "s5_b_im": nrm(ks[15], (L, S5_GROUPS, S5_STATE, S5_GROUP), (2.0 * S5_GROUP) ** -0.5),
        "s5_c_re": nrm(ks[16], (L, S5_GROUPS, S5_GROUP, S5_STATE), 1.0),
        "s5_c_im": nrm(ks[17], (L, S5_GROUPS, S5_GROUP, S5_STATE), 1.0),
        "s5_d": nrm(ks[18], (L, D_S5), 0.5),
        "s5_glu_w": nrm(ks[19], (L, D_S5, D_S5), D_S5 ** -0.5),
        "s5_glu_b": nrm(ks[20], (L, D_S5), 0.01),
        "rg_out_norm": 1.0 + nrm(ks[21], (L, D_RGLRU), 0.02),
        "s5_out_norm": 1.0 + nrm(ks[22], (L, D_S5), 0.02),
        "w_out": nrm(ks[23], (L, D_MIX, D_MODEL), D_MIX ** -0.5),
        "ffn2_norm": 1.0 + nrm(ks[24], (L, D_MODEL), 0.02),
        "ffn2_w_gate": nrm(ks[25], (L, D_MODEL, D_FF), D_MODEL ** -0.5),
        "ffn2_w_up": nrm(ks[26], (L, D_MODEL, D_FF), D_MODEL ** -0.5),
        "ffn2_w_down": nrm(ks[27], (L, D_FF, D_MODEL), D_FF ** -0.5),
        "final_norm": 1.0 + nrm(ks[28], (D_MODEL,), 0.02),
    }


def reference(x, meta_tokens, ffn1_norm, ffn1_w_gate, ffn1_w_up, ffn1_w_down, mix_norm, w_in,
              rg_conv_w, rg_conv_b, rg_w_a, rg_b_a, rg_w_x, rg_b_x, rg_lambda,
              s5_lambda_re, s5_lambda_im, s5_log_dt, s5_b_re, s5_b_im, s5_c_re, s5_c_im, s5_d,
              s5_glu_w, s5_glu_b, rg_out_norm, s5_out_norm, w_out,
              ffn2_norm, ffn2_w_gate, ffn2_w_up, ffn2_w_down, final_norm):
    bsz = x.shape[0]
    meta = jnp.broadcast_to(meta_tokens[None].astype(x.dtype), (bsz, N_META, D_MODEL))
    h = jnp.concatenate([meta, x], axis=1)
    for l in range(DEPTH):
        h = h + 0.5 * swiglu(rmsnorm(h, ffn1_norm[l]), ffn1_w_gate[l], ffn1_w_up[l], ffn1_w_down[l])
        proj = rmsnorm(h, mix_norm[l]) @ w_in[l]
        u_rg, g_rg, u_s5 = jnp.split(proj, [D_RGLRU, 2 * D_RGLRU], axis=-1)
        y_rg = rg_lru_mixer(u_rg, g_rg, rg_conv_w[l], rg_conv_b[l], rg_w_a[l], rg_b_a[l],
                            rg_w_x[l], rg_b_x[l], rg_lambda[l])
        y_s5 = s5_mixer(u_s5, s5_lambda_re[l], s5_lambda_im[l], s5_log_dt[l], s5_b_re[l], s5_b_im[l],
                        s5_c_re[l], s5_c_im[l], s5_d[l], s5_glu_w[l], s5_glu_b[l])
        y = jnp.concatenate([rmsnorm(y_rg, rg_out_norm[l]), rmsnorm(y_s5, s5_out_norm[l])], axis=-1)
        h = h + y @ w_out[l]
        h = h + 0.5 * swiglu(rmsnorm(h, ffn2_norm[l]), ffn2_w_gate[l], ffn2_w_up[l], ffn2_w_down[l])
    out = rmsnorm(h, final_norm)
    return out[:, N_META:]
```

```cpp
#include <hip/hip_runtime.h>
#include <cstdio>
#include <cstdint>

#ifndef MK_N_LAUNCHES
#define MK_N_LAUNCHES 1
#endif

namespace pg8 {
#define PG8_LAS __attribute__((address_space(3)))
typedef unsigned short bf16_t;
typedef short bf16x8 __attribute__((ext_vector_type(8)));
typedef float f32x4 __attribute__((ext_vector_type(4)));
typedef unsigned u32x4 __attribute__((ext_vector_type(4)));
constexpr int BM = 256, BK = 64, HALF = 128, HTB = HALF * BK * 2, STAGE_BYTES = 8 * HTB, NXCD = 8, WGM = 8;

__host__ __device__ __forceinline__ int lds_byte(int r, int c) { const int st = (r >> 4) * 2 + (c >> 5), rr = r & 15, cc = c & 31, ob = rr * 64 + cc * 2; return st * 1024 + (ob ^ (((ob >> 9) & 1) << 5)); }
__host__ __device__ __forceinline__ void stage_rc(int b, int& R, int& C) { const int st = b / 1024, sb = b % 1024, swz = sb ^ (((sb >> 9) & 1) << 5); R = (st >> 1) * 16 + swz / 64; C = (st & 1) * 32 + (swz % 64) / 2; }
__host__ __device__ __forceinline__ int perm32(int rho) { const int n = rho >> 4, i = rho & 15; return 8 * (i >> 2) + 4 * n + (i & 3); }

__device__ __forceinline__ int lane_id_opaque() { int l; asm volatile("v_mbcnt_lo_u32_b32 %0, -1, 0\n\tv_mbcnt_hi_u32_b32 %0, -1, %0" : "=v"(l)); return l; }
struct Unit { int pm, pn; };
struct Gemm { const bf16_t* A; const bf16_t* Bt; int lda, ldb, K, a_shift; unsigned a_stride; };

struct StaticOrder {
    int nM, nN, nwg, G, c;
    __device__ void init(int nM_, int nN_, int G_, int c_) { nM = nM_; nN = nN_; nwg = nM * nN; G = G_; c = c_; }
    __device__ bool next(int i, Unit& u) const {
        const long L = (long)i * G + c; if (L >= nwg) return false;
        int wgid = (int)L; { const int q = nwg / NXCD, r = nwg % NXCD, xcd = wgid % NXCD, off = wgid / NXCD; wgid = (xcd < r ? xcd * (q + 1) : r * (q + 1) + (xcd - r) * q) + off; }
        const int nig = WGM * nN, gid = wgid / nig, fm = gid * WGM, gsz = (nM - fm) < WGM ? (nM - fm) : WGM;
        u.pm = fm + ((wgid % nig) % gsz); u.pn = (wgid % nig) / gsz; return true;
    }
};

__device__ __forceinline__ unsigned cvt_pk_bf16(float lo, float hi) { unsigned r; asm volatile("v_cvt_pk_bf16_f32 %0, %1, %2" : "=v"(r) : "v"(lo), "v"(hi)); return r; }

template <class Epi, bool ALIGN_EPI, bool SP2>
__device__ __forceinline__ void gemm_phase(PG8_LAS unsigned char* lds, const int wid, const Gemm g, const StaticOrder& S, const Epi& E) {
    const int lane = lane_id_opaque(), tid = wid * 64 + lane, wr = wid >> 2, wc = wid & 3, fr = lane & 15, fq = lane >> 4;
    const int K = g.K, nt = K / BK;
    unsigned voffA[2], voffB[2];
#pragma unroll
    for (int i = 0; i < 2; ++i) { int R, C; stage_rc(tid * 16 + i * 8192, R, C); const int Rb = (R & ~31) + perm32(R & 31);
        voffA[i] = (unsigned)(R * g.lda + C) * 2u; voffB[i] = (unsigned)(Rb * g.ldb + C) * 2u; }
    const size_t kstep = (size_t)(BK * 2);
    const size_t hA = (size_t)HALF * g.lda * 2, hB = (size_t)HALF * g.ldb * 2;
    const size_t tA = 2 * hA, tB = 2 * hB;
    const unsigned ldsw = (unsigned)wid * 1024u;
    const int aoff = lds_byte(wr * 64 + fr, fq * 8), boff = lds_byte(wc * 32 + fr, fq * 8);
#define PG8_SA(b, h) (((b) * 2 + (h)) * HTB)
#define PG8_SB(b, h) ((4 + (b) * 2 + (h)) * HTB)
#define PG8_STAGE(bufoff, gbase, voff) do { _Pragma("unroll") for (int _i = 0; _i < 2; ++_i) \
        __builtin_amdgcn_global_load_lds((const unsigned*)((const char*)(gbase) + (voff)[_i]), (PG8_LAS unsigned*)(lds + (bufoff) + ldsw + _i * 8192), 16, 0, 0); } while (0)
#define PG8_LDA(dst, b, h) do { _Pragma("unroll") for (int m = 0; m < 4; ++m) _Pragma("unroll") for (int k = 0; k < 2; ++k) dst[m][k] = *(const PG8_LAS bf16x8*)(lds + PG8_SA(b, h) + aoff + m * 2048 + k * 1024); } while (0)
#define PG8_LDB(dst, b, h) do { _Pragma("unroll") for (int n = 0; n < 2; ++n) _Pragma("unroll") for (int k = 0; k < 2; ++k) dst[n][k] = *(const PG8_LAS bf16x8*)(lds + PG8_SB(b, h) + boff + n * 2048 + k * 1024); } while (0)
#define PG8_MMA(ai, bj, At, Bt) do { __builtin_amdgcn_s_setprio(1); _Pragma("unroll") for (int m = 0; m < 4; ++m) _Pragma("unroll") for (int n = 0; n < 2; ++n) _Pragma("unroll") for (int k = 0; k < 2; ++k) \
        acc[ai][bj][m][n] = __builtin_amdgcn_mfma_f32_16x16x32_bf16(Bt[n][k], At[m][k], acc[ai][bj][m][n], 0, 0, 0); __builtin_amdgcn_s_setprio(0); } while (0)
#define PG8_WAIT_V(n) asm volatile("s_waitcnt vmcnt(" #n ")" ::: "memory")
#define PG8_WAIT_L(n) asm volatile("s_waitcnt lgkmcnt(" #n ")" ::: "memory")
#define PG8_BAR __builtin_amdgcn_s_barrier()
#define PG8_SCHED __builtin_amdgcn_sched_barrier(0)
    Unit cur, nxt; int ui = 0;
    if (!S.next(0, cur)) return;
    f32x4 acc[2][2][4][2];
#pragma unroll
    for (int a = 0; a < 2; ++a)
#pragma unroll
        for (int b = 0; b < 2; ++b)
#pragma unroll
            for (int m = 0; m < 4; ++m)
#pragma unroll
                for (int n = 0; n < 2; ++n) acc[a][b][m][n] = (f32x4){0.f, 0.f, 0.f, 0.f};
    bf16x8 At[4][2], B0[2][2], B1[2][2];
    const char* cA = (const char*)g.A + (size_t)cur.pm * tA + (size_t)(cur.pn >> g.a_shift) * g.a_stride; const char* cB = (const char*)g.Bt + (size_t)cur.pn * tB;
    if constexpr (SP2) {
        PG8_STAGE(PG8_SB(0, 0), cB, voffB); PG8_STAGE(PG8_SB(0, 1), cB + hB, voffB); PG8_STAGE(PG8_SA(0, 0), cA, voffA); PG8_STAGE(PG8_SA(0, 1), cA + hA, voffA);
        if (wr == 1) PG8_BAR;
        PG8_WAIT_V(2); PG8_BAR;
        PG8_STAGE(PG8_SB(1, 0), cB + kstep, voffB); PG8_STAGE(PG8_SA(1, 0), cA + kstep, voffA); PG8_STAGE(PG8_SB(1, 1), cB + hB + kstep, voffB);
        PG8_WAIT_V(6); PG8_BAR;
    } else {
        PG8_STAGE(PG8_SB(0, 0), cB, voffB); PG8_STAGE(PG8_SA(0, 0), cA, voffA); PG8_STAGE(PG8_SB(0, 1), cB + hB, voffB); PG8_STAGE(PG8_SA(0, 1), cA + hA, voffA);
        if (wr == 1) PG8_BAR;
        PG8_WAIT_V(4); PG8_BAR;
        PG8_STAGE(PG8_SB(1, 0), cB + kstep, voffB); PG8_STAGE(PG8_SA(1, 0), cA + kstep, voffA); PG8_STAGE(PG8_SB(1, 1), cB + hB + kstep, voffB);
        PG8_WAIT_V(6); PG8_BAR;
    }
    for (;;) {
        const bool has_next = S.next(ui + 1, nxt);
        const char* nA = has_next ? (const char*)g.A + (size_t)nxt.pm * tA + (size_t)(nxt.pn >> g.a_shift) * g.a_stride : cA; const char* nB = has_next ? (const char*)g.Bt + (size_t)nxt.pn * tB : cB;
#pragma nounroll
        for (int t = 0; t < nt; t += 2) {
            const bool last = (t == nt - 2);
            const char* a1 = cA + (size_t)(t + 1) * kstep;
            const char* a2 = last ? nA : cA + (size_t)(t + 2) * kstep; const char* b2 = last ? nB : cB + (size_t)(t + 2) * kstep;
            const char* a3 = a2 + kstep; const char* b3 = b2 + kstep;
            if constexpr (SP2) {
            PG8_LDB(B0, 0, 0); PG8_LDB(B1, 0, 1); PG8_SCHED; PG8_LDA(At, 0, 0); PG8_STAGE(PG8_SA(1, 1), a1 + hA, voffA);
            PG8_WAIT_V(8); PG8_WAIT_L(0); PG8_BAR; PG8_MMA(0, 0, At, B0); PG8_MMA(0, 1, At, B1); PG8_BAR; PG8_SCHED;
            PG8_LDA(At, 0, 1); PG8_STAGE(PG8_SB(0, 0), b2, voffB); PG8_STAGE(PG8_SB(0, 1), b2 + hB, voffB); PG8_STAGE(PG8_SA(0, 0), a2, voffA);
            PG8_WAIT_V(8); PG8_WAIT_L(0); PG8_BAR; PG8_MMA(1, 0, At, B0); PG8_MMA(1, 1, At, B1); PG8_BAR; PG8_SCHED;
            PG8_LDB(B0, 1, 0); PG8_LDB(B1, 1, 1); PG8_SCHED; PG8_LDA(At, 1, 0); PG8_STAGE(PG8_SA(0, 1), a2 + hA, voffA);
            PG8_WAIT_V(8); PG8_WAIT_L(0); PG8_BAR; PG8_MMA(0, 0, At, B0); PG8_MMA(0, 1, At, B1); PG8_BAR; PG8_SCHED;
            PG8_LDA(At, 1, 1); PG8_STAGE(PG8_SB(1, 0), b3, voffB); PG8_STAGE(PG8_SB(1, 1), b3 + hB, voffB); PG8_STAGE(PG8_SA(1, 0), a3, voffA);
            PG8_WAIT_V(8); PG8_WAIT_L(0); PG8_BAR; PG8_MMA(1, 0, At, B0); PG8_MMA(1, 1, At, B1); PG8_BAR; PG8_SCHED;
            } else {
            PG8_LDB(B0, 0, 0); PG8_SCHED; PG8_LDA(At, 0, 0); PG8_STAGE(PG8_SA(1, 1), a1 + hA, voffA);
            PG8_WAIT_L(8); PG8_BAR; PG8_WAIT_L(0); PG8_MMA(0, 0, At, B0); PG8_BAR; PG8_SCHED;
            PG8_LDB(B1, 0, 1); PG8_STAGE(PG8_SB(0, 0), b2, voffB);
            PG8_BAR; PG8_WAIT_L(0); PG8_MMA(0, 1, At, B1); PG8_BAR;
            PG8_LDA(At, 0, 1); PG8_STAGE(PG8_SA(0, 0), a2, voffA);
            PG8_BAR; PG8_WAIT_L(0); PG8_MMA(1, 0, At, B0); PG8_BAR; PG8_SCHED;
            PG8_STAGE(PG8_SB(0, 1), b2 + hB, voffB);
            PG8_WAIT_V(6); PG8_BAR; PG8_MMA(1, 1, At, B1); PG8_BAR;
            PG8_LDB(B0, 1, 0); PG8_SCHED; PG8_LDA(At, 1, 0); PG8_STAGE(PG8_SA(0, 1), a2 + hA, voffA);
            PG8_WAIT_L(8); PG8_BAR; PG8_WAIT_L(0); PG8_MMA(0, 0, At, B0); PG8_BAR; PG8_SCHED;
            PG8_LDB(B1, 1, 1); PG8_STAGE(PG8_SB(1, 0), b3, voffB);
            PG8_BAR; PG8_WAIT_L(0); PG8_MMA(0, 1, At, B1); PG8_BAR;
            PG8_LDA(At, 1, 1); PG8_STAGE(PG8_SA(1, 0), a3, voffA);
            PG8_BAR; PG8_WAIT_L(0); PG8_MMA(1, 0, At, B0); PG8_BAR; PG8_SCHED;
            PG8_STAGE(PG8_SB(1, 1), b3 + hB, voffB);
            PG8_WAIT_V(6); PG8_BAR; PG8_MMA(1, 1, At, B1); PG8_BAR;
            }
        }
        if constexpr (ALIGN_EPI) { if (wr == 0) PG8_BAR; }
        E(acc, cur, wr, wc, fr, fq);
        if (!has_next) break;
#pragma unroll
        for (int a = 0; a < 2; ++a)
#pragma unroll
            for (int b = 0; b < 2; ++b)
#pragma unroll
                for (int m = 0; m < 4; ++m)
#pragma unroll
                    for (int n = 0; n < 2; ++n) acc[a][b][m][n] = (f32x4){0.f, 0.f, 0.f, 0.f};
        cur = nxt; cA = nA; cB = nB; ++ui;
        if constexpr (ALIGN_EPI) { if (wr == 1) PG8_BAR; }
    }
    PG8_WAIT_V(0);
    if constexpr (!ALIGN_EPI) { if (wr == 0) PG8_BAR; }
    PG8_BAR;
#undef PG8_SA
#undef PG8_SB
#undef PG8_STAGE
#undef PG8_LDA
#undef PG8_LDB
#undef PG8_MMA
#undef PG8_WAIT_V
#undef PG8_WAIT_L
#undef PG8_BAR
#undef PG8_SCHED
}
}

constexpr int NWAVES = 8, NTHR = 512;
constexpr int D = 4096, FF = 11008, MX = 16384, MP = 16640, NPX = 64, NPP = 65;
constexpr int DR = 2048, DS = 2048, NG = 128, SL = 16  , NCHX = 1024, NCHP = 1040, UK = 384  ;
constexpr int NSEG = 16, SEGL = 256;
constexpr float EPS = 1e-6f;
constexpr int N_PHASES = 14;

constexpr size_t MiB = 1u << 20;
constexpr size_t CTL_ZERO_BYTES = 1 * MiB;
constexpr size_t al(size_t x) { return (x + MiB - 1) / MiB * MiB; }
constexpr size_t WS_CTL = 0;
constexpr size_t WS_W1GU = al(WS_CTL + CTL_ZERO_BYTES);
constexpr size_t WS_W1D  = al(WS_W1GU + (size_t)2 * FF * D * 2);
constexpr size_t WS_WIN  = al(WS_W1D + (size_t)D * FF * 2);
constexpr size_t WS_WRG  = al(WS_WIN + (size_t)6144 * D * 2);
constexpr size_t WS_WGLU = al(WS_WRG + (size_t)4096 * 256 * 2);
constexpr size_t WS_WOUT = al(WS_WGLU + (size_t)DS * DS * 2);
constexpr size_t WS_S5TQ = al(WS_WOUT + (size_t)D * D * 2);
constexpr size_t WS_S5P  = al(WS_S5TQ + (size_t)NG * 256 * UK * 2);
constexpr size_t WS_S5BB = al(WS_S5P + (size_t)NG * 256 * 256 * 2);
constexpr size_t WS_S5LAM = al(WS_S5BB + (size_t)NG * 64 * 16 * 2 * 4);
constexpr size_t WS_SEG  = al(WS_S5LAM + (size_t)NG * 64 * 4 * 4);
constexpr size_t WS_C8   = al(WS_SEG + (size_t)2 * 4 * NSEG * DR * 4);
constexpr size_t WS_H0M  = al(WS_C8 + (size_t)DR * 4);
constexpr size_t WS_AX   = al(WS_H0M + (size_t)256 * D * 4);
constexpr size_t WS_AX2  = al(WS_AX + (size_t)MP * D * 2);
constexpr size_t WS_H    = al(WS_AX2 + (size_t)MP * D * 2);
constexpr size_t WS_HB   = al(WS_H + (size_t)MP * FF * 2);
constexpr size_t WS_END  = al(WS_HB + (size_t)MP * D * 4);
constexpr size_t WS_GG   = WS_H;
constexpr size_t WS_U    = al(WS_GG + (size_t)MP * DR * 2);
constexpr size_t WS_XCB  = al(WS_U + (size_t)NG * NCHP * UK * 2);
constexpr size_t WS_Z    = al(WS_XCB + (size_t)MP * DR * 2);
static_assert(WS_Z + (size_t)MX * DS * 2 <= WS_HB, "mixer overlays fit in H");
constexpr size_t DO_UA = 0, DO_E = al((size_t)MP * DR * 4);
static_assert(DO_E + (size_t)NG * NCHX * 128 * 4 <= (size_t)MX * D * 4, "d_out scratch");
constexpr int CW_BAR = 4096;
constexpr int CW_SS = 65536;
static_assert((CW_SS + 4 * MP) * 4 <= (int)CTL_ZERO_BYTES, "ctl");

constexpr int RING_BYTES = 131072, MISC_OFF = RING_BYTES + 320, LDS_BYTES = 147456;

#define LAS __attribute__((address_space(3)))
typedef unsigned short bf16;
typedef unsigned v4u __attribute__((ext_vector_type(4)));
typedef unsigned v2u __attribute__((ext_vector_type(2)));
typedef float f32x4 __attribute__((ext_vector_type(4)));
typedef float f32x2 __attribute__((ext_vector_type(2)));
#define LDS_WAIT() asm volatile("s_waitcnt lgkmcnt(0)" ::: "memory")
#define VM_WAIT() asm volatile("s_waitcnt vmcnt(0)" ::: "memory")
using pg8::cvt_pk_bf16;
__device__ __forceinline__ float bf_lo(unsigned w) { return __uint_as_float(w << 16); }
__device__ __forceinline__ float bf_hi(unsigned w) { return __uint_as_float(w & 0xffff0000u); }
__device__ __forceinline__ float fsigmoid(float v) { return __builtin_amdgcn_rcpf(1.0f + __builtin_amdgcn_exp2f(-1.4426950408889634f * v)); }
__device__ __forceinline__ float gelu_tanh(float x) { const float u = x * (1.0f + 0.044715f * x * x); return x * fsigmoid(1.5957691216057308f * u); }
__device__ __forceinline__ float wave_sum(float v) {
#pragma unroll
    for (int o = 1; o < 64; o <<= 1) v += __shfl_xor(v, o);
    return v;
}

#define XB_TMO      128
#define XB_XCNT(j)  (256  + 64 * (j))
#define XB_XSUB(j)  (1280 + 64 * (j))
#define XB_XGEN(j)  (2304 + 64 * (j))
#define XB_TOP      3328
#define XB_TOPGEN   3392
#define XCD_BAR_WORDS 3456
#define XB_SPIN_CAP (1u << 18)
__device__ __forceinline__ unsigned xb_ld(unsigned* p)              { return __hip_atomic_load(p, __ATOMIC_RELAXED, __HIP_MEMORY_SCOPE_AGENT); }
__device__ __forceinline__ unsigned xb_add(unsigned* p, unsigned v) { return __hip_atomic_fetch_add(p, v, __ATOMIC_RELAXED, __HIP_MEMORY_SCOPE_AGENT); }
__device__ __forceinline__ unsigned xb_xcc_id() { return (unsigned)__builtin_amdgcn_s_getreg((3 << 11) | 20) & 0xFu; }
#define XB_SPIN(cond, bar) do { unsigned _sp = 0; while (cond) { __builtin_amdgcn_s_sleep(1); \
    if ((++_sp & 255u) == 0u) { if (xb_ld(&(bar)[XB_TMO])) break; if (_sp > XB_SPIN_CAP) { atomicAdd(&(bar)[XB_TMO], 1u); break; } } } } while (0)
struct XcdBarrier { unsigned* bar; unsigned x; volatile LAS unsigned* st; };
__device__ __forceinline__ XcdBarrier xcd_barrier_post(unsigned* bar, volatile LAS unsigned* st) {
    XcdBarrier b; b.bar = bar; b.x = xb_xcc_id(); b.st = st;
    if (threadIdx.x == 0) (void)xb_add(&bar[XB_XCNT(b.x)], 1u);
    return b;
}
__device__ __forceinline__ void xcd_barrier_complete(unsigned* bar, unsigned x, unsigned& nloc, unsigned& nx) {
    const unsigned G = gridDim.x * gridDim.y * gridDim.z;
    unsigned sum, cnt, mine, sp = 0u;
    for (;;) {
        sum = 0u; cnt = 0u; mine = 0u;
#pragma unroll
        for (unsigned j = 0; j < 16; ++j) { const unsigned c = xb_ld(&bar[XB_XCNT(j)]); sum += c; cnt += (c > 0u) ? 1u : 0u; mine = (j == x) ? c : mine; }
        if (sum == G) break;
        __builtin_amdgcn_s_sleep(1);
        if ((++sp & 255u) == 0u) { if (xb_ld(&bar[XB_TMO])) break; if (sp > XB_SPIN_CAP) { atomicAdd(&bar[XB_TMO], 1u); break; } }
    }
    nloc = mine > 0u ? mine : 1u; nx = cnt > 0u ? cnt : 1u;
}
__device__ __forceinline__ void xcd_barrier(const XcdBarrier& b) {
    asm volatile("s_waitcnt vmcnt(0)" ::: "memory");
    __syncthreads();
    if (threadIdx.x == 0) {
        unsigned* bar = b.bar;
        __builtin_amdgcn_s_waitcnt(0);
        unsigned nloc = b.st[0], nx = b.st[1];
        if (nloc == 0u) { xcd_barrier_complete(bar, b.x, nloc, nx); b.st[0] = nloc; b.st[1] = nx; }
        const unsigned old = xb_add(&bar[XB_XSUB(b.x)], 1u);
        const unsigned gen = old / nloc;
        if (old + 1u == (gen + 1u) * nloc) {
            __builtin_amdgcn_fence(__ATOMIC_RELEASE, "agent");
            asm volatile("s_waitcnt vmcnt(0)" ::: "memory");
            const unsigned og = xb_add(&bar[XB_TOP], 1u);
            const unsigned tg = og / nx;
            if (og + 1u == (tg + 1u) * nx) xb_add(&bar[XB_TOPGEN], 1u);
            else XB_SPIN(xb_ld(&bar[XB_TOPGEN]) == tg, bar);
            __builtin_amdgcn_fence(__ATOMIC_ACQUIRE, "agent");
            xb_add(&bar[XB_XGEN(b.x)], 1u);
            asm volatile("s_waitcnt vmcnt(0)" ::: "memory");
        } else {
            XB_SPIN(xb_ld(&bar[XB_XGEN(b.x)]) == gen, bar);
            __builtin_amdgcn_fence(__ATOMIC_ACQUIRE, "agent");
            asm volatile("s_waitcnt vmcnt(0)" ::: "memory");
        }
    }
    __syncthreads();
}

using pg8::Unit;
#define EPI_ARGS const f32x4 (&acc)[2][2][4][2], const Unit& u, int wr, int wc, int fr, int fq
#define ROWLOOP _Pragma("unroll") for (int ai = 0; ai < 2; ++ai) _Pragma("unroll") for (int m = 0; m < 4; ++m)

template <bool RS> struct EpiSwiglu {
    bf16* H; const float* ss;
    __device__ __forceinline__ void operator()(EPI_ARGS) const {
        const int row0 = u.pm * 256 + wr * 64 + fr, j0 = u.pn * 128 + wc * 32 + 8 * fq;
        ROWLOOP { const int row = row0 + ai * 128 + m * 16;
            float rs = 1.0f; if (RS) rs = __builtin_amdgcn_rsqf(ss[row] * (1.0f / D) + EPS);
            float h[8];
#pragma unroll
            for (int n = 0; n < 2; ++n)
#pragma unroll
                for (int e = 0; e < 4; ++e) { const float gv = acc[ai][0][m][n][e] * rs, uv = acc[ai][1][m][n][e] * rs; h[n * 4 + e] = gv * uv * fsigmoid(gv); }
            v4u w; w.x = cvt_pk_bf16(h[0], h[1]); w.y = cvt_pk_bf16(h[2], h[3]); w.z = cvt_pk_bf16(h[4], h[5]); w.w = cvt_pk_bf16(h[6], h[7]);
            *(v4u*)(H + (size_t)row * FF + j0) = w; }
    }
};
struct EpiResid {
    const float* base; const float* base_meta; float* outf; const float* gain; bf16* outb; float* outg; float* ss; float scale;
    __device__ __forceinline__ void operator()(EPI_ARGS) const {
        const int row0 = u.pm * 256 + wr * 64 + fr;
        const float* bp = (u.pm < NPX) ? base : (base_meta - (size_t)MX * D);
        float sq[2][4];
        ROWLOOP sq[ai][m] = 0.f;
#pragma unroll
        for (int bj = 0; bj < 2; ++bj) { const int c0 = u.pn * 256 + bj * 128 + wc * 32 + 8 * fq;
            const f32x4 g0 = *(const f32x4*)(gain + c0), g1 = *(const f32x4*)(gain + c0 + 4);
            ROWLOOP { const size_t off = (size_t)(row0 + ai * 128 + m * 16) * D + c0;
                const f32x4 b0 = *(const f32x4*)(bp + off), b1 = *(const f32x4*)(bp + off + 4);
                const f32x4 v0 = b0 + acc[ai][bj][m][0] * scale, v1 = b1 + acc[ai][bj][m][1] * scale;
                if (outf) { *(f32x4*)(outf + off) = v0; *(f32x4*)(outf + off + 4) = v1; }
                sq[ai][m] += (v0[0] * v0[0] + v0[1] * v0[1]) + (v0[2] * v0[2] + v0[3] * v0[3]) + (v1[0] * v1[0] + v1[1] * v1[1]) + (v1[2] * v1[2] + v1[3] * v1[3]);
                const f32x4 w0 = v0 * g0, w1 = v1 * g1;
                if (outb) { v4u w; w.x = cvt_pk_bf16(w0[0], w0[1]); w.y = cvt_pk_bf16(w0[2], w0[3]); w.z = cvt_pk_bf16(w1[0], w1[1]); w.w = cvt_pk_bf16(w1[2], w1[3]); *(v4u*)(outb + off) = w; }
                if (outg) { *(f32x4*)(outg + off) = w0; *(f32x4*)(outg + off + 4) = w1; } } }
        ROWLOOP { float s = sq[ai][m]; s += __shfl_xor(s, 16); s += __shfl_xor(s, 32);
            if (fq == 0) atomicAdd(ss + row0 + ai * 128 + m * 16, s); }
    }
};
struct EpiWin {
    const float* ss; float* urg; bf16* gg; bf16* U;
    __device__ __forceinline__ void operator()(EPI_ARGS) const {
        const int row0 = u.pm * 256 + wr * 64 + fr;
        ROWLOOP { const int row = row0 + ai * 128 + m * 16;
            const float rs = __builtin_amdgcn_rsqf(ss[row] * (1.0f / D) + EPS);
#pragma unroll
            for (int bj = 0; bj < 2; ++bj) { const int c0 = u.pn * 256 + bj * 128 + wc * 32 + 8 * fq;
                const f32x4 v0 = acc[ai][bj][m][0] * rs, v1 = acc[ai][bj][m][1] * rs;
                if (u.pn < 8) { float* p = urg + (size_t)row * DR + c0; *(f32x4*)p = v0; *(f32x4*)(p + 4) = v1; }
                else if (u.pn < 16) { v4u w; w.x = cvt_pk_bf16(gelu_tanh(v0[0]), gelu_tanh(v0[1])); w.y = cvt_pk_bf16(gelu_tanh(v0[2]), gelu_tanh(v0[3]));
                    w.z = cvt_pk_bf16(gelu_tanh(v1[0]), gelu_tanh(v1[1])); w.w = cvt_pk_bf16(gelu_tanh(v1[2]), gelu_tanh(v1[3])); *(v4u*)(gg + (size_t)row * DR + (c0 - 2048)) = w; }
                else { const int cs = c0 - 4096, g = cs >> 4, cp = cs & 15;
                    v4u w; w.x = cvt_pk_bf16(v0[0], v0[1]); w.y = cvt_pk_bf16(v0[2], v0[3]); w.z = cvt_pk_bf16(v1[0], v1[1]); w.w = cvt_pk_bf16(v1[2], v1[3]);
                    *(v4u*)(U + ((size_t)g * NCHP + (row >> 4)) * UK + (row & 15) * 16 + cp) = w; } } }
    }
};
__device__ __forceinline__ float one_minus_exp(float x) {
    const float big = 1.0f - __builtin_amdgcn_exp2f(1.4426950408889634f * x);
    const float small = -x * (1.0f + x * (0.5f + x * (0.16666667f + x * 0.041666668f)));
    return (x > -0.0625f) ? small : big;
}
struct EpiGates {
    const float* b_a; const float* b_x; const float* c8t; float* xcbx; float* Aout;
    __device__ __forceinline__ void operator()(EPI_ARGS) const {
        const int row0 = u.pm * 256 + wr * 64 + fr, ch0 = (u.pn >> 1) * 256 + (u.pn & 1) * 128 + wc * 32 + 8 * fq;
        const f32x4 ba0 = *(const f32x4*)(b_a + ch0), ba1 = *(const f32x4*)(b_a + ch0 + 4), bx0 = *(const f32x4*)(b_x + ch0), bx1 = *(const f32x4*)(b_x + ch0 + 4);
        const f32x4 c80 = *(const f32x4*)(c8t + ch0), c81 = *(const f32x4*)(c8t + ch0 + 4);
        ROWLOOP { const size_t off = (size_t)(row0 + ai * 128 + m * 16) * DR + ch0;
            const f32x4 x0 = *(const f32x4*)(xcbx + off), x1 = *(const f32x4*)(xcbx + off + 4);
            f32x4 a0, a1, o0, o1;
#pragma unroll
            for (int e = 0; e < 4; ++e) {
                { const float r = fsigmoid(acc[ai][0][m][0][e] + ba0[e]), ig = fsigmoid(acc[ai][1][m][0][e] + bx0[e]); const float la = c80[e] * r;
                  a0[e] = __builtin_amdgcn_exp2f(1.4426950408889634f * la); o0[e] = __builtin_amdgcn_sqrtf(one_minus_exp(2.0f * la)) * ig * x0[e]; }
                { const float r = fsigmoid(acc[ai][0][m][1][e] + ba1[e]), ig = fsigmoid(acc[ai][1][m][1][e] + bx1[e]); const float la = c81[e] * r;
                  a1[e] = __builtin_amdgcn_exp2f(1.4426950408889634f * la); o1[e] = __builtin_amdgcn_sqrtf(one_minus_exp(2.0f * la)) * ig * x1[e]; } }
            *(f32x4*)(Aout + off) = a0; *(f32x4*)(Aout + off + 4) = a1; *(f32x4*)(xcbx + off) = o0; *(f32x4*)(xcbx + off + 4) = o1; }
    }
};
struct EpiS5E {
    float* E;
    __device__ __forceinline__ void operator()(EPI_ARGS) const {
        const int row0 = u.pm * 256 + wr * 64 + fr, c0 = wc * 32 + 8 * fq;
        ROWLOOP { float* p = E + ((size_t)u.pn * NCHX + row0 + ai * 128 + m * 16) * 128 + c0; *(f32x4*)p = acc[ai][0][m][0]; *(f32x4*)(p + 4) = acc[ai][0][m][1]; }
    }
};
struct EpiS5Y {
    bf16* Z;
    __device__ __forceinline__ void operator()(EPI_ARGS) const {
        const int row0 = u.pm * 256 + wr * 64 + fr;
        ROWLOOP { const int j = row0 + ai * 128 + m * 16;
#pragma unroll
            for (int bj = 0; bj < 2; ++bj) { const int col = bj * 128 + wc * 32 + 8 * fq, t = col >> 4, cp = col & 15;
                const f32x4 v0 = acc[ai][bj][m][0], v1 = acc[ai][bj][m][1];
                v4u w; w.x = cvt_pk_bf16(gelu_tanh(v0[0]), gelu_tanh(v0[1])); w.y = cvt_pk_bf16(gelu_tanh(v0[2]), gelu_tanh(v0[3]));
                w.z = cvt_pk_bf16(gelu_tanh(v1[0]), gelu_tanh(v1[1])); w.w = cvt_pk_bf16(gelu_tanh(v1[2]), gelu_tanh(v1[3]));
                *(v4u*)(Z + (size_t)(j * 16 + t) * DS + u.pn * 16 + cp) = w; } }
    }
};
struct EpiGlu {
    const bf16* Z; const float* bias; const float* gain; float* yg; float* ss;
    __device__ __forceinline__ void operator()(EPI_ARGS) const {
        const int row0 = u.pm * 256 + wr * 64 + fr;
        float sq[2][4];
        ROWLOOP sq[ai][m] = 0.f;
#pragma unroll
        for (int bj = 0; bj < 2; ++bj) { const int c0 = u.pn * 256 + bj * 128 + wc * 32 + 8 * fq;
            const f32x4 b0 = *(const f32x4*)(bias + c0), b1 = *(const f32x4*)(bias + c0 + 4), g0 = *(const f32x4*)(gain + c0), g1 = *(const f32x4*)(gain + c0 + 4);
            ROWLOOP { const size_t off = (size_t)(row0 + ai * 128 + m * 16) * DS + c0;
                const v4u zw = *(const v4u*)(Z + off);
                const f32x4 z0 = {bf_lo(zw.x), bf_hi(zw.x), bf_lo(zw.y), bf_hi(zw.y)}, z1 = {bf_lo(zw.z), bf_hi(zw.z), bf_lo(zw.w), bf_hi(zw.w)};
                f32x4 y0, y1;
#pragma unroll
                for (int e = 0; e < 4; ++e) { y0[e] = z0[e] * fsigmoid(acc[ai][bj][m][0][e] + b0[e]); y1[e] = z1[e] * fsigmoid(acc[ai][bj][m][1][e] + b1[e]); }
                sq[ai][m] += (y0[0] * y0[0] + y0[1] * y0[1]) + (y0[2] * y0[2] + y0[3] * y0[3]) + (y1[0] * y1[0] + y1[1] * y1[1]) + (y1[2] * y1[2] + y1[3] * y1[3]);
                *(f32x4*)(yg + off) = y0 * g0; *(f32x4*)(yg + off + 4) = y1 * g1; } }
        ROWLOOP { float s = sq[ai][m]; s += __shfl_xor(s, 16); s += __shfl_xor(s, 32);
            if (fq == 0) atomicAdd(ss + row0 + ai * 128 + m * 16, s); }
    }
};

struct Args { const float* in[33]; float* out; unsigned char* ws; int ph_lo, ph_hi; };
enum { I_X = 0, I_META, I_N1, I_WG1, I_WU1, I_WD1, I_NMIX, I_WIN, I_CONVW, I_CONVB, I_WA, I_BA, I_WX, I_BX, I_LAM, I_S5LRE, I_S5LIM, I_S5LDT, I_S5BRE, I_S5BIM, I_S5CRE, I_S5CIM,
       I_S5D, I_GLUW, I_GLUB, I_NRG, I_NS5, I_WOUT, I_N2, I_WG2, I_WU2, I_WD2, I_NFIN };

__device__ __forceinline__ void cvt_item(const float* W, int N, bf16* WT, int ldk, int k0, int n0, int dest_row0, LAS float* scr, int lane) {
#pragma unroll 8
    for (int i = 0; i < 32; ++i) { const int kk = 2 * i + (lane >> 5); scr[kk * 33 + (lane & 31)] = W[(size_t)(k0 + kk) * N + n0 + (lane & 31)]; }
    LDS_WAIT(); asm volatile("" ::: "memory");
    const int c = lane & 7;
#pragma unroll
    for (int j = 0; j < 4; ++j) { const int n = (lane >> 3) + 8 * j; const LAS float* s = scr + (8 * c) * 33 + n;
        v4u o; o.x = cvt_pk_bf16(s[0 * 33], s[1 * 33]); o.y = cvt_pk_bf16(s[2 * 33], s[3 * 33]); o.z = cvt_pk_bf16(s[4 * 33], s[5 * 33]); o.w = cvt_pk_bf16(s[6 * 33], s[7 * 33]);
        *(v4u*)(WT + (size_t)(dest_row0 + n) * ldk + k0 + 8 * c) = o; }
    LDS_WAIT(); asm volatile("" ::: "memory");
}
__device__ __forceinline__ void cvt_plain(const float* W, int K, int N, bf16* WT, LAS float* scr, int gw, int NGW, int lane) {
    const int nblk = N / 32, nit = (K / 64) * nblk;
    for (int it = gw; it < nit; it += NGW) { const int kb = it / nblk, nb = it % nblk; cvt_item(W, N, WT, K, kb * 64, nb * 32, nb * 32, scr, lane); }
}
__device__ __forceinline__ void cvt_gu(const float* W, int K, int N, bf16* WT, int half, LAS float* scr, int gw, int NGW, int lane) {
    const int nblk = N / 32, nit = (K / 64) * nblk;
    for (int it = gw; it < nit; it += NGW) { const int kb = it / nblk, nb = it % nblk, n0 = nb * 32; cvt_item(W, N, WT, K, kb * 64, n0, (n0 >> 7) * 256 + half * 128 + (n0 & 127), scr, lane); }
}

struct Ctx { LAS unsigned char* lds; int wave, vcu, G; };
#define PHASE_IDS const int lane_ = pg8::lane_id_opaque(); const int tid_ = F.wave * 64 + lane_;

__device__ __forceinline__ void s5_tables(const Args& a, const Ctx& F, int g) {
    PHASE_IDS
    LAS f32x2* pw = (LAS f32x2*)(F.lds);
    LAS f32x2* bb = (LAS f32x2*)(F.lds + 8704);
    LAS f32x2* cc = (LAS f32x2*)(F.lds + 8704 + 8192);
    LAS float* Kt = (LAS float*)(F.lds + 8704 + 16384);
    const float dt = expf(a.in[I_S5LDT][g]);
    const float* lre = a.in[I_S5LRE] + g * 64; const float* lim = a.in[I_S5LIM] + g * 64;
    float* BBg = (float*)(a.ws + WS_S5BB); float* LAMg = (float*)(a.ws + WS_S5LAM);
    for (int idx = tid_; idx < 17 * 64; idx += NTHR) { const int tau = idx >> 6, n = idx & 63;
        const float mag = expf((float)tau * lre[n] * dt); float s, c; sincosf((float)tau * lim[n] * dt, &s, &c); pw[idx] = (f32x2){mag * c, mag * s}; }
    for (int idx = tid_; idx < 64 * 16; idx += NTHR) { const int n = idx >> 4, c = idx & 15;
        const float x = lre[n] * dt, th = lim[n] * dt, e1 = expm1f(x); float s, co; sincosf(th, &s, &co); const float sh = sinf(0.5f * th);
        const float nr = e1 * co - 2.0f * sh * sh, ni = (e1 + 1.0f) * s;
        const float ar = lre[n], ai = lim[n], den = 1.0f / (ar * ar + ai * ai);
        const float qr = (nr * ar + ni * ai) * den, qi = (ni * ar - nr * ai) * den;
        const float br = a.in[I_S5BRE][(g * 64 + n) * 16 + c], bi = a.in[I_S5BIM][(g * 64 + n) * 16 + c];
        const f32x2 v = {qr * br - qi * bi, qr * bi + qi * br};
        bb[idx] = v; *(f32x2*)(BBg + ((size_t)(g * 64 + n) * 16 + c) * 2) = v; }
    for (int idx = tid_; idx < 16 * 64; idx += NTHR) { const int c = idx >> 6, n = idx & 63; cc[idx] = (f32x2){a.in[I_S5CRE][(g * 16 + c) * 64 + n], a.in[I_S5CIM][(g * 16 + c) * 64 + n]}; }
    __syncthreads();
    if (tid_ < 64) { const f32x2 l1 = pw[64 + tid_], l16 = pw[16 * 64 + tid_]; *(f32x4*)(LAMg + (size_t)(g * 64 + tid_) * 4) = (f32x4){l1.x, l1.y, l16.x, l16.y}; }
    for (int idx = tid_; idx < 4096; idx += NTHR) { const int tau = idx >> 8, c = (idx >> 4) & 15, cp = idx & 15; float s = 0.f;
        for (int n = 0; n < 64; ++n) { const f32x2 C = cc[c * 64 + n], P = pw[tau * 64 + n], B = bb[n * 16 + cp];
            const float qr = C.x * P.x - C.y * P.y, qi = C.x * P.y + C.y * P.x; s += qr * B.x - qi * B.y; }
        if (tau == 0 && c == cp) s += a.in[I_S5D][g * 16 + c];
        Kt[idx] = s; }
    __syncthreads();
    bf16* TQ = (bf16*)(a.ws + WS_S5TQ) + (size_t)g * 256 * UK; bf16* PP = (bf16*)(a.ws + WS_S5P) + (size_t)g * 256 * 256;
    for (int idx = tid_; idx < 256 * 48; idx += NTHR) { const int rho = idx / 48, kc = idx % 48, t = rho >> 4, c = rho & 15; float v[8];
        if (kc < 32) { const int s = kc >> 1, cp0 = (kc & 1) * 8;
#pragma unroll
            for (int e = 0; e < 8; ++e) v[e] = (t >= s) ? Kt[((t - s) * 16 + c) * 16 + cp0 + e] : 0.f; }
        else { const int n0 = (kc - 32) * 4;
#pragma unroll
            for (int e = 0; e < 4; ++e) { const f32x2 C = cc[c * 64 + n0 + e], P = pw[(t + 1) * 64 + n0 + e]; v[2 * e] = C.x * P.x - C.y * P.y; v[2 * e + 1] = -(C.x * P.y + C.y * P.x); } }
        v4u w; w.x = cvt_pk_bf16(v[0], v[1]); w.y = cvt_pk_bf16(v[2], v[3]); w.z = cvt_pk_bf16(v[4], v[5]); w.w = cvt_pk_bf16(v[6], v[7]);
        *(v4u*)(TQ + (size_t)rho * UK + kc * 8) = w; }
    for (int idx = tid_; idx < 256 * 32; idx += NTHR) { const int rho = idx >> 5, kc = idx & 31, s = kc >> 1, cp0 = (kc & 1) * 8; float v[8];
#pragma unroll
        for (int e = 0; e < 8; ++e) v[e] = 0.f;
        if (rho < 128) { const int n = rho >> 1; const f32x2 P = pw[(15 - s) * 64 + n];
#pragma unroll
            for (int e = 0; e < 8; ++e) { const f32x2 B = bb[n * 16 + cp0 + e]; v[e] = (rho & 1) ? (P.x * B.y + P.y * B.x) : (P.x * B.x - P.y * B.y); } }
        v4u w; w.x = cvt_pk_bf16(v[0], v[1]); w.y = cvt_pk_bf16(v[2], v[3]); w.z = cvt_pk_bf16(v[4], v[5]); w.w = cvt_pk_bf16(v[6], v[7]);
        *(v4u*)(PP + (size_t)rho * 256 + kc * 8) = w; }
    __syncthreads();
}

__device__ __forceinline__ void p0_prologue(const Args& a, const Ctx& F) {
    PHASE_IDS
    for (int g = F.vcu; g < NG; g += F.G) s5_tables(a, F, g);
    LAS float* scr = (LAS float*)(F.lds + F.wave * 16384);
    const int gw = F.vcu * NWAVES + F.wave, NGW = F.G * NWAVES;
    cvt_gu(a.in[I_WG1], D, FF, (bf16*)(a.ws + WS_W1GU), 0, scr, gw, NGW, lane_);
    cvt_gu(a.in[I_WU1], D, FF, (bf16*)(a.ws + WS_W1GU), 1, scr, gw, NGW, lane_);
    cvt_plain(a.in[I_WD1], FF, D, (bf16*)(a.ws + WS_W1D), scr, gw, NGW, lane_);
    cvt_plain(a.in[I_WIN], D, 6144, (bf16*)(a.ws + WS_WIN), scr, gw, NGW, lane_);
    cvt_plain(a.in[I_GLUW], DS, DS, (bf16*)(a.ws + WS_WGLU), scr, gw, NGW, lane_);
    cvt_plain(a.in[I_WOUT], D, D, (bf16*)(a.ws + WS_WOUT), scr, gw, NGW, lane_);
    for (int it = gw; it < 512; it += NGW) { const int h = it >> 6, which = (it >> 5) & 1, kb = (it >> 3) & 3, nb = it & 7, n0 = nb * 32;
        cvt_item(a.in[which ? I_WX : I_WA] + (size_t)h * 65536, 256, (bf16*)(a.ws + WS_WRG), 256, kb * 64, n0, (h * 2 + (n0 >> 7)) * 256 + which * 128 + (n0 & 127), scr, lane_); }
    for (int i = F.vcu * NTHR + tid_; i < DR; i += F.G * NTHR) ((float*)(a.ws + WS_C8))[i] = -8.0f * log1pf(expf(-a.in[I_LAM][i]));
    bf16* A1 = (bf16*)(a.ws + WS_AX); float* H0M = (float*)(a.ws + WS_H0M); const float* g1 = a.in[I_N1];
    for (int m = gw; m < MP; m += NGW) {
        f32x4 v[16];
        if (m < MX + 16) { const float* src = (m < MX) ? a.in[I_X] + (size_t)m * D : a.in[I_META] + (size_t)(m - MX) * D;
#pragma unroll
            for (int j = 0; j < 16; ++j) v[j] = *(const f32x4*)(src + 4 * lane_ + 256 * j); }
        else {
#pragma unroll
            for (int j = 0; j < 16; ++j) v[j] = (f32x4){0.f, 0.f, 0.f, 0.f}; }
        float s = 0.f;
#pragma unroll
        for (int j = 0; j < 16; ++j) s += (v[j][0] * v[j][0] + v[j][1] * v[j][1]) + (v[j][2] * v[j][2] + v[j][3] * v[j][3]);
        const float rs = __builtin_amdgcn_rsqf(wave_sum(s) * (1.0f / D) + EPS);
#pragma unroll
        for (int j = 0; j < 16; ++j) { const int c = 4 * lane_ + 256 * j; const f32x4 gv = *(const f32x4*)(g1 + c); const f32x4 o = v[j] * rs * gv;
            v2u w; w.x = cvt_pk_bf16(o[0], o[1]); w.y = cvt_pk_bf16(o[2], o[3]); *(v2u*)(A1 + (size_t)m * D + c) = w;
            if (m >= MX) *(f32x4*)(H0M + (size_t)(m - MX) * D + c) = v[j]; }
    }
}

__device__ __forceinline__ void p4_conv(const Args& a, const Ctx& F) {
    PHASE_IDS
    const float* ur = a.out + DO_UA / 4; float* xc = (float*)(a.ws + WS_AX); bf16* xcb = (bf16*)(a.ws + WS_XCB);
    const float* cw = a.in[I_CONVW]; const float* cb = a.in[I_CONVB];
    for (int idx = F.vcu * NTHR + tid_; idx < MP * 512; idx += F.G * NTHR) { const int row = idx >> 9, c4 = (idx & 511) * 4;
        f32x4 s = *(const f32x4*)(cb + c4);
#pragma unroll
        for (int k = 0; k < 4; ++k) { int srow;
            if (row < MX) { const int tt = (row & 4095) - 3 + k; srow = tt >= 0 ? (row & ~4095) + tt : MX + 16 + tt; }
            else { const int tt = (row - MX) - 3 + k; srow = tt >= 0 ? MX + tt : -1; }
            if (srow >= 0) s += *(const f32x4*)(cw + k * DR + c4) * *(const f32x4*)(ur + (size_t)srow * DR + c4); }
        *(f32x4*)(xc + (size_t)row * DR + c4) = s;
        v2u w; w.x = cvt_pk_bf16(s[0], s[1]); w.y = cvt_pk_bf16(s[2], s[3]); *(v2u*)(xcb + (size_t)row * DR + c4) = w; }
    LAS float* scr = (LAS float*)(F.lds + F.wave * 16384);
    const int gw = F.vcu * NWAVES + F.wave, NGW = F.G * NWAVES;
    cvt_gu(a.in[I_WG2], D, FF, (bf16*)(a.ws + WS_W1GU), 0, scr, gw, NGW, lane_);
    cvt_gu(a.in[I_WU2], D, FF, (bf16*)(a.ws + WS_W1GU), 1, scr, gw, NGW, lane_);
    cvt_plain(a.in[I_WD2], FF, D, (bf16*)(a.ws + WS_W1D), scr, gw, NGW, lane_);
}

__device__ __forceinline__ void p6_scans(const Args& a, const Ctx& F) {
    PHASE_IDS
    float* Aa = a.out + DO_UA / 4; float* BX = (float*)(a.ws + WS_AX);
    float* segP = (float*)(a.ws + WS_SEG); float* segH = segP + 4 * NSEG * DR;
    for (int w = F.vcu; w < 256; w += F.G) { const int b = w >> 6, seg = (w >> 2) & 15, ch = (w & 3) * 512 + tid_;
        const size_t base = ((size_t)b * 4096 + seg * SEGL) * DR + ch;
        float h = 0.f, P = 1.f;
        for (int t0 = 0; t0 < SEGL; t0 += 8) { float av[8], xv[8];
#pragma unroll
            for (int j = 0; j < 8; ++j) { av[j] = Aa[base + (size_t)(t0 + j) * DR]; xv[j] = BX[base + (size_t)(t0 + j) * DR]; }
#pragma unroll
            for (int j = 0; j < 8; ++j) { h = av[j] * h + xv[j]; P *= av[j]; BX[base + (size_t)(t0 + j) * DR] = h; Aa[base + (size_t)(t0 + j) * DR] = P; } }
        segP[(b * NSEG + seg) * DR + ch] = P; segH[(b * NSEG + seg) * DR + ch] = h; }
    if (F.wave < 2) {
        bf16* U = (bf16*)(a.ws + WS_U); const float* E = a.out + DO_E / 4; const float* BBg = (const float*)(a.ws + WS_S5BB); const float* LAMg = (const float*)(a.ws + WS_S5LAM);
        for (int item = F.vcu * 2 + F.wave; item < 4 * NG; item += 2 * F.G) { const int b = item >> 7, g = item & 127, n = lane_;
            const f32x4 lm = *(const f32x4*)(LAMg + (size_t)(g * 64 + n) * 4);
            f32x4 bq[8];
#pragma unroll
            for (int j = 0; j < 8; ++j) bq[j] = *(const f32x4*)(BBg + (size_t)(g * 64 + n) * 32 + 4 * j);
            float sr = 0.f, si = 0.f;
            const bf16* um = U + ((size_t)g * NCHP + NCHX) * UK;
            for (int s = 0; s < 16; ++s) { const v4u w0 = *(const v4u*)(um + s * 16), w1 = *(const v4u*)(um + s * 16 + 8);
                const float uu[16] = {bf_lo(w0.x), bf_hi(w0.x), bf_lo(w0.y), bf_hi(w0.y), bf_lo(w0.z), bf_hi(w0.z), bf_lo(w0.w), bf_hi(w0.w),
                                      bf_lo(w1.x), bf_hi(w1.x), bf_lo(w1.y), bf_hi(w1.y), bf_lo(w1.z), bf_hi(w1.z), bf_lo(w1.w), bf_hi(w1.w)};
                float br = 0.f, bi = 0.f;
#pragma unroll
                for (int j = 0; j < 8; ++j) { br += bq[j][0] * uu[2 * j] + bq[j][2] * uu[2 * j + 1]; bi += bq[j][1] * uu[2 * j] + bq[j][3] * uu[2 * j + 1]; }
                const float nr = lm[0] * sr - lm[1] * si + br, ni = lm[0] * si + lm[1] * sr + bi; sr = nr; si = ni; }
            bf16* up = U + ((size_t)g * NCHP + b * 256) * UK + 256 + 2 * n; const float* ep = E + ((size_t)g * NCHX + b * 256) * 128 + 2 * n;
            for (int k0 = 0; k0 < 256; k0 += 8) { f32x2 ev[8];
#pragma unroll
                for (int j = 0; j < 8; ++j) ev[j] = *(const f32x2*)(ep + (size_t)(k0 + j) * 128);
#pragma unroll
                for (int j = 0; j < 8; ++j) { *(unsigned*)(up + (size_t)(k0 + j) * UK) = cvt_pk_bf16(sr, si);
                    const float nr = lm[2] * sr - lm[3] * si + ev[j].x, ni = lm[2] * si + lm[3] * sr + ev[j].y; sr = nr; si = ni; } } }
    }
}

__device__ __forceinline__ void p7_rgfix(const Args& a, const Ctx& F) {
    PHASE_IDS
    const float* Aa = a.out + DO_UA / 4; const float* BX = (const float*)(a.ws + WS_AX); const bf16* GG = (const bf16*)(a.ws + WS_GG);
    const float* segP = (const float*)(a.ws + WS_SEG); const float* segH = segP + 4 * NSEG * DR; const float* gn = a.in[I_NRG];
    bf16* AO = (bf16*)(a.ws + WS_AX2);
    LAS f32x4* carry = (LAS f32x4*)(F.lds);
    for (int w = F.vcu; w < 256; w += F.G) { const int b = w >> 6, seg = (w >> 2) & 15, q = w & 3;
        { const int c4 = tid_ * 4; f32x4 h = {0.f, 0.f, 0.f, 0.f};
            for (int r = 0; r < 16; ++r) h = *(const f32x4*)(Aa + (size_t)(MX + r) * DR + c4) * h + *(const f32x4*)(BX + (size_t)(MX + r) * DR + c4);
            for (int s = 0; s < seg; ++s) h = *(const f32x4*)(segP + (size_t)(b * NSEG + s) * DR + c4) * h + *(const f32x4*)(segH + (size_t)(b * NSEG + s) * DR + c4);
            carry[tid_] = h; }
        __syncthreads();
        for (int rr = 0; rr < 8; ++rr) { const int row = b * 4096 + seg * SEGL + q * 64 + F.wave * 8 + rr;
            f32x4 y[8]; float s = 0.f;
#pragma unroll
            for (int j = 0; j < 8; ++j) { const int c = 4 * lane_ + 256 * j; const size_t off = (size_t)row * DR + c;
                const f32x4 hl = *(const f32x4*)(BX + off), ac = *(const f32x4*)(Aa + off), cr = carry[lane_ + 64 * j]; const v2u gw2 = *(const v2u*)(GG + off);
                const f32x4 gv = {bf_lo(gw2.x), bf_hi(gw2.x), bf_lo(gw2.y), bf_hi(gw2.y)};
                y[j] = (hl + ac * cr) * gv; s += (y[j][0] * y[j][0] + y[j][1] * y[j][1]) + (y[j][2] * y[j][2] + y[j][3] * y[j][3]); }
            const float rs = __builtin_amdgcn_rsqf(wave_sum(s) * (1.0f / DR) + EPS);
#pragma unroll
            for (int j = 0; j < 8; ++j) { const int c = 4 * lane_ + 256 * j; const f32x4 o = y[j] * rs * *(const f32x4*)(gn + c);
                v2u wv; wv.x = cvt_pk_bf16(o[0], o[1]); wv.y = cvt_pk_bf16(o[2], o[3]); *(v2u*)(AO + (size_t)row * D + c) = wv; } }
        __syncthreads(); }
}

__device__ __forceinline__ void p9_s5norm(const Args& a, const Ctx& F) {
    PHASE_IDS
    const float* yg = (const float*)(a.ws + WS_AX); const float* ss = (const float*)(a.ws + WS_CTL) + CW_SS + 3 * MP; bf16* AO = (bf16*)(a.ws + WS_AX2);
    const int gw = F.vcu * NWAVES + F.wave, NGW = F.G * NWAVES;
    for (int m = gw; m < MX; m += NGW) { const float rs = __builtin_amdgcn_rsqf(ss[m] * (1.0f / DS) + EPS);
#pragma unroll
        for (int j = 0; j < 8; ++j) { const int c = 4 * lane_ + 256 * j; const f32x4 o = *(const f32x4*)(yg + (size_t)m * DS + c) * rs;
            v2u wv; wv.x = cvt_pk_bf16(o[0], o[1]); wv.y = cvt_pk_bf16(o[2], o[3]); *(v2u*)(AO + (size_t)m * D + DR + c) = wv; } }
}

__device__ __forceinline__ void p13_final(const Args& a, const Ctx& F) {
    PHASE_IDS
    const float* ss = (const float*)(a.ws + WS_CTL) + CW_SS + 2 * MP;
    const int gw = F.vcu * NWAVES + F.wave, NGW = F.G * NWAVES;
    for (int m = gw; m < MX; m += NGW) { const float rs = __builtin_amdgcn_rsqf(ss[m] * (1.0f / D) + EPS);
#pragma unroll
        for (int j = 0; j < 16; ++j) { float* p = a.out + (size_t)m * D + 4 * lane_ + 256 * j; *(f32x4*)p = *(const f32x4*)p * rs; } }
}

__global__ void __launch_bounds__(NTHR, 2) hymba_fwd(Args a) {
    extern __shared__ __attribute__((aligned(16))) unsigned char lds_raw[];
    Ctx F; F.lds = (LAS unsigned char*)lds_raw; F.wave = __builtin_amdgcn_readfirstlane((int)threadIdx.x >> 6);
    F.G = gridDim.x; { const int bx = blockIdx.x; F.vcu = (F.G % 8 == 0) ? (bx % 8) * (F.G / 8) + bx / 8 : bx; }
    volatile LAS unsigned* MISC = (volatile LAS unsigned*)(F.lds + MISC_OFF);
    for (int u = threadIdx.x; u < (LDS_BYTES - RING_BYTES) / 4; u += NTHR) ((LAS unsigned*)(F.lds + RING_BYTES))[u] = 0u;
    __syncthreads();
    unsigned* ctl = (unsigned*)(a.ws + WS_CTL);
    XcdBarrier bar; bar.bar = ctl + CW_BAR; bar.x = 0; bar.st = nullptr;
    if (MK_N_LAUNCHES == 1) bar = xcd_barrier_post(ctl + CW_BAR, MISC + 8);
    const int lo = a.ph_lo, hi = a.ph_hi;
#define IN(k) (lo <= (k) && (k) < hi)
#define SEAM(k) do { if (IN(k) && IN((k) + 1)) xcd_barrier(bar); } while (0)
    float* ssb = (float*)ctl + CW_SS;
    bf16* AX = (bf16*)(a.ws + WS_AX); bf16* HH = (bf16*)(a.ws + WS_H); float* HB = (float*)(a.ws + WS_HB);
    const int me = (int)blockIdx.x;

    if (IN(0)) { p0_prologue(a, F); } SEAM(0);
    if (IN(1)) {
        pg8::Gemm g{AX, (const bf16*)(a.ws + WS_W1GU), D, D, D, 0, 0u}; pg8::StaticOrder S; S.init(NPP, 2 * FF / 256, F.G, me);
        EpiSwiglu<false> E{HH, nullptr};
        pg8::gemm_phase<EpiSwiglu<false>, true, true>(F.lds, F.wave, g, S, E); } SEAM(1);
    if (IN(2)) {
        pg8::Gemm g{HH, (const bf16*)(a.ws + WS_W1D), FF, FF, FF, 0, 0u}; pg8::StaticOrder S; S.init(NPP, D / 256, F.G, me);
        EpiResid E{a.in[I_X], (const float*)(a.ws + WS_H0M), HB, a.in[I_NMIX], AX, nullptr, ssb, 0.5f};
        pg8::gemm_phase<EpiResid, true, true>(F.lds, F.wave, g, S, E); } SEAM(2);
    if (IN(3)) {
        pg8::Gemm g{AX, (const bf16*)(a.ws + WS_WIN), D, D, D, 0, 0u}; pg8::StaticOrder S; S.init(NPP, 6144 / 256, F.G, me);
        EpiWin E{ssb, a.out + DO_UA / 4, (bf16*)(a.ws + WS_GG), (bf16*)(a.ws + WS_U)};
        pg8::gemm_phase<EpiWin, true, true>(F.lds, F.wave, g, S, E); } SEAM(3);
    if (IN(4)) { p4_conv(a, F); } SEAM(4);
    if (IN(5)) {
        { pg8::Gemm g{(const bf16*)(a.ws + WS_XCB), (const bf16*)(a.ws + WS_WRG), DR, 256, 256, 1, 512u}; pg8::StaticOrder S; S.init(NPP, 16, F.G, me);
          EpiGates E{a.in[I_BA], a.in[I_BX], (const float*)(a.ws + WS_C8), (float*)(a.ws + WS_AX), a.out + DO_UA / 4};
          pg8::gemm_phase<EpiGates, true, true>(F.lds, F.wave, g, S, E); }
        { pg8::Gemm g{(const bf16*)(a.ws + WS_U), (const bf16*)(a.ws + WS_S5P), UK, 256, 256, 0, (unsigned)(NCHP * UK * 2)}; pg8::StaticOrder S; S.init(4, NG, F.G, me);
          EpiS5E E{a.out + DO_E / 4};
          pg8::gemm_phase<EpiS5E, true, true>(F.lds, F.wave, g, S, E); } } SEAM(5);
    if (IN(6)) { p6_scans(a, F); } SEAM(6);
    if (IN(7)) {
        p7_rgfix(a, F);
        { pg8::Gemm g{(const bf16*)(a.ws + WS_U), (const bf16*)(a.ws + WS_S5TQ), UK, UK, UK, 0, (unsigned)(NCHP * UK * 2)}; pg8::StaticOrder S; S.init(4, NG, F.G, me);
          EpiS5Y E{(bf16*)(a.ws + WS_Z)};
          pg8::gemm_phase<EpiS5Y, true, true>(F.lds, F.wave, g, S, E); } } SEAM(7);
    if (IN(8)) {
        pg8::Gemm g{(const bf16*)(a.ws + WS_Z), (const bf16*)(a.ws + WS_WGLU), DS, DS, DS, 0, 0u}; pg8::StaticOrder S; S.init(NPX, DS / 256, F.G, me);
        EpiGlu E{(const bf16*)(a.ws + WS_Z), a.in[I_GLUB], a.in[I_NS5], (float*)(a.ws + WS_AX), ssb + 3 * MP};
        pg8::gemm_phase<EpiGlu, true, true>(F.lds, F.wave, g, S, E); } SEAM(8);
    if (IN(9)) { p9_s5norm(a, F); } SEAM(9);
    if (IN(10)) {
        pg8::Gemm g{(const bf16*)(a.ws + WS_AX2), (const bf16*)(a.ws + WS_WOUT), D, D, D, 0, 0u}; pg8::StaticOrder S; S.init(NPX, D / 256, F.G, me);
        EpiResid E{HB, HB, HB, a.in[I_N2], AX, nullptr, ssb + MP, 1.0f};
        pg8::gemm_phase<EpiResid, true, true>(F.lds, F.wave, g, S, E); } SEAM(10);
    if (IN(11)) {
        pg8::Gemm g{AX, (const bf16*)(a.ws + WS_W1GU), D, D, D, 0, 0u}; pg8::StaticOrder S; S.init(NPX, 2 * FF / 256, F.G, me);
        EpiSwiglu<true> E{HH, ssb + MP};
        pg8::gemm_phase<EpiSwiglu<true>, true, true>(F.lds, F.wave, g, S, E); } SEAM(11);
    if (IN(12)) {
        pg8::Gemm g{HH, (const bf16*)(a.ws + WS_W1D), FF, FF, FF, 0, 0u}; pg8::StaticOrder S; S.init(NPX, D / 256, F.G, me);
        EpiResid E{HB, HB, nullptr, a.in[I_NFIN], nullptr, a.out, ssb + 2 * MP, 0.5f};
        pg8::gemm_phase<EpiResid, true, true>(F.lds, F.wave, g, S, E); } SEAM(12);
    if (IN(13)) { p13_final(a, F); }
#undef IN
#undef SEAM
}

extern "C" void kernel_launch(void* const* d_in, const int* in_sizes, int n_in, void* d_out, int out_size, void* d_ws, size_t ws_size, hipStream_t stream) {
    static int grid = 0;
    if (grid == 0) {
        if (n_in != 33 || in_sizes[0] != MX * D || out_size != MX * D || ws_size < WS_END) { fprintf(stderr, "kernel_launch: shape/workspace mismatch (n_in %d, ws %zu < %zu)\n", n_in, ws_size, (size_t)WS_END); grid = -1; return; }
        int dev = 0, cus = 0, per_cu = 0;
        if (hipGetDevice(&dev) != hipSuccess || hipDeviceGetAttribute(&cus, hipDeviceAttributeMultiprocessorCount, dev) != hipSuccess) { grid = -1; return; }
        if (hipFuncSetAttribute((const void*)hymba_fwd, hipFuncAttributeMaxDynamicSharedMemorySize, LDS_BYTES) != hipSuccess) { fprintf(stderr, "kernel_launch: hipFuncSetAttribute failed\n"); grid = -1; return; }
        if (hipOccupancyMaxActiveBlocksPerMultiprocessor(&per_cu, (const void*)hymba_fwd, NTHR, LDS_BYTES) != hipSuccess || per_cu < 1) fprintf(stderr, "kernel_launch: occupancy query says %d\n", per_cu);
        (void)hipGetLastError();
        grid = cus;
    }
    if (grid < 0) return;
    if (hipMemsetAsync((char*)d_ws + WS_CTL, 0, CTL_ZERO_BYTES, stream) != hipSuccess) return;
    Args a{};
    for (int i = 0; i < 33; ++i) a.in[i] = (const float*)d_in[i];
    a.out = (float*)d_out; a.ws = (unsigned char*)d_ws;
    if (MK_N_LAUNCHES == 1) { a.ph_lo = 0; a.ph_hi = N_PHASES; hipLaunchKernelGGL(hymba_fwd, dim3(grid), dim3(NTHR), LDS_BYTES, stream, a); }
    else for (int p = 0; p < N_PHASES; ++p) { a.ph_lo = p; a.ph_hi = p + 1; hipLaunchKernelGGL(hymba_fwd, dim3(grid), dim3(NTHR), LDS_BYTES, stream, a); }
    const hipError_t le = hipPeekAtLastError();
    if (le != hipSuccess) fprintf(stderr, "kernel_launch: launch failed: %s\n", hipGetErrorName(le));
}
```

```cpp
#include <hip/hip_runtime.h>
#include <cstdio>
#include <cstdint>

#ifndef PROBE_DUP
#define PROBE_DUP -1
#endif
#ifndef PROBE_SPIN
#define PROBE_SPIN -1
#endif
#ifndef PROBE_A
#define PROBE_A 30
#define PROBE_B 31
#define PROBE_MUL 1
#define PROBE_BLK 0
#endif
#ifndef PROBE_GP
#define PROBE_GP 2
#endif
#ifndef MK_N_LAUNCHES
#define MK_N_LAUNCHES 1
#endif

namespace pg8 {
#define PG8_LAS __attribute__((address_space(3)))
typedef unsigned short bf16_t;
typedef short bf16x8 __attribute__((ext_vector_type(8)));
typedef float f32x4 __attribute__((ext_vector_type(4)));
typedef unsigned u32x4 __attribute__((ext_vector_type(4)));
typedef int i32x4 __attribute__((ext_vector_type(4)));
template <bool I8> struct AccT { typedef f32x4 type; }; template <> struct AccT<true> { typedef i32x4 type; };
__device__ __forceinline__ f32x4 mma16(bf16x8 b, bf16x8 a, f32x4 c) { return __builtin_amdgcn_mfma_f32_16x16x32_bf16(b, a, c, 0, 0, 0); }
__device__ __forceinline__ i32x4 mma16(bf16x8 b, bf16x8 a, i32x4 c) { return __builtin_amdgcn_mfma_i32_16x16x64_i8(__builtin_bit_cast(i32x4, b), __builtin_bit_cast(i32x4, a), c, 0, 0, 0); }
constexpr int BM = 256, BK = 64, HALF = 128, HTB = HALF * BK * 2, STAGE_BYTES = 8 * HTB, NXCD = 8, WGM = 8;

__host__ __device__ __forceinline__ int lds_byte(int r, int c) { const int st = (r >> 4) * 2 + (c >> 5), rr = r & 15, cc = c & 31, ob = rr * 64 + cc * 2; return st * 1024 + (ob ^ (((ob >> 9) & 1) << 5)); }
__host__ __device__ __forceinline__ void stage_rc(int b, int& R, int& C) { const int st = b / 1024, sb = b % 1024, swz = sb ^ (((sb >> 9) & 1) << 5); R = (st >> 1) * 16 + swz / 64; C = (st & 1) * 32 + (swz % 64) / 2; }
__host__ __device__ __forceinline__ int perm32(int rho) { const int n = rho >> 4, i = rho & 15; return 8 * (i >> 2) + 4 * n + (i & 3); }

__device__ __forceinline__ int lane_id_opaque() { int l; asm volatile("v_mbcnt_lo_u32_b32 %0, -1, 0\n\tv_mbcnt_hi_u32_b32 %0, -1, %0" : "=v"(l)); return l; }
struct Unit { int pm, pn; };
struct Gemm { const bf16_t* A; const bf16_t* Bt; int lda, ldb, K, a_shift; unsigned a_stride; };

struct StaticOrder {
    int nM, nN, nwg, G, c, chunked, wb;
    __device__ __forceinline__ void init(int nM_, int nN_, int G_, int c_, int chunked_ = 0, int wb_ = 16) { nM = nM_; nN = nN_; nwg = nM * nN; G = G_; c = c_; chunked = chunked_; wb = wb_; }
    __device__ __forceinline__ bool next(int i, Unit& u) const {
        const long L = (long)i * G + c; if (L >= nwg) return false;
        if (chunked) { const int CP = chunked, per_chunk = CP * nN, nch = nM / CP;
            int ch = (int)L / per_chunk, w = (int)L % per_chunk;
            if (ch >= nch) { const int e = (int)L - nch * per_chunk; u.pm = nch * CP + e / nN; u.pn = e % nN; return true; }
            const int full = (nN / wb) * CP * wb; int jb, r, wbj;
            if (w < full) { jb = w / (CP * wb); r = w % (CP * wb); wbj = wb; } else { jb = nN / wb; r = w - full; wbj = nN % wb; }
            const int gy = 32 / CP, xcd = r & 7, loc = r >> 3, pq = wbj / gy;
            u.pm = ch * CP + (xcd / gy) * 4 + (loc & 3); u.pn = jb * wb + (xcd % gy) * pq + (loc >> 2); return true; }
        int wgid = (int)L; { const int q = nwg / NXCD, r = nwg % NXCD, xcd = wgid % NXCD, off = wgid / NXCD; wgid = (xcd < r ? xcd * (q + 1) : r * (q + 1) + (xcd - r) * q) + off; }
        const int nig = WGM * nN, gid = wgid / nig, fm = gid * WGM, gsz = (nM - fm) < WGM ? (nM - fm) : WGM;
        u.pm = fm + ((wgid % nig) % gsz); u.pn = (wgid % nig) / gsz; return true;
    }
};

__device__ __forceinline__ unsigned cvt_pk_bf16(float lo, float hi) { unsigned r; asm volatile("v_cvt_pk_bf16_f32 %0, %1, %2" : "=v"(r) : "v"(lo), "v"(hi)); return r; }

template <class Epi, bool ALIGN_EPI, bool SP2, bool HOOK = false, bool STAMPS = false, bool I8 = false>
__device__ __forceinline__ void gemm_phase(PG8_LAS unsigned char* lds, const int wid, const Gemm g, const StaticOrder& S, const Epi& E, const unsigned long long* hss = nullptr, float hinv = 0.f, float heps = 0.f, unsigned long long* st = nullptr) {
    const int lane = lane_id_opaque(), tid = wid * 64 + lane, wr = wid >> 2, wc = wid & 3, fr = lane & 15, fq = lane >> 4;
    const int K = g.K, nt = K / BK;
    unsigned voffA[2], voffB[2];
#pragma unroll
    for (int i = 0; i < 2; ++i) { int R, C; stage_rc(tid * 16 + i * 8192, R, C); const int Rb = (R & ~31) + perm32(R & 31);
        voffA[i] = (unsigned)(R * g.lda + C) * 2u; voffB[i] = (unsigned)(Rb * g.ldb + C) * 2u; }
    const size_t kstep = (size_t)(BK * 2);
    const size_t hA = (size_t)HALF * g.lda * 2, hB = (size_t)HALF * g.ldb * 2;
    const size_t tA = 2 * hA, tB = 2 * hB;
    const unsigned ldsw = (unsigned)wid * 1024u;
    const int aoff = lds_byte(wr * 64 + fr, fq * 8), boff = lds_byte(wc * 32 + fr, fq * 8);
#define PG8_SA(b, h) (((b) * 2 + (h)) * HTB)
#define PG8_SB(b, h) ((4 + (b) * 2 + (h)) * HTB)
#define PG8_STAGE(bufoff, gbase, voff) do { _Pragma("unroll") for (int _i = 0; _i < 2; ++_i) \
        __builtin_amdgcn_global_load_lds((const unsigned*)((const char*)(gbase) + (voff)[_i]), (PG8_LAS unsigned*)(lds + (bufoff) + ldsw + _i * 8192), 16, 0, 0); } while (0)
#define PG8_LDA(dst, b, h) do { _Pragma("unroll") for (int m = 0; m < 4; ++m) _Pragma("unroll") for (int k = 0; k < 2; ++k) dst[m][k] = *(const PG8_LAS bf16x8*)(lds + PG8_SA(b, h) + aoff + m * 2048 + k * 1024); } while (0)
#define PG8_LDB(dst, b, h) do { _Pragma("unroll") for (int n = 0; n < 2; ++n) _Pragma("unroll") for (int k = 0; k < 2; ++k) dst[n][k] = *(const PG8_LAS bf16x8*)(lds + PG8_SB(b, h) + boff + n * 2048 + k * 1024); } while (0)
#define PG8_MMA(ai, bj, At, Bt) do { __builtin_amdgcn_s_setprio(1); _Pragma("unroll") for (int m = 0; m < 4; ++m) _Pragma("unroll") for (int n = 0; n < 2; ++n) _Pragma("unroll") for (int k = 0; k < 2; ++k) \
        acc[ai][bj][m][n] = mma16(Bt[n][k], At[m][k], acc[ai][bj][m][n]); __builtin_amdgcn_s_setprio(0); } while (0)
#define PG8_WAIT_V(n) asm volatile("s_waitcnt vmcnt(" #n ")" ::: "memory")
#define PG8_WAIT_L(n) asm volatile("s_waitcnt lgkmcnt(" #n ")" ::: "memory")
#define PG8_BAR __builtin_amdgcn_s_barrier()
#define PG8_SCHED __builtin_amdgcn_sched_barrier(0)
#define PG8_ST(k) do { if constexpr (STAMPS) { if (wid == 0 && lane == 0 && blockIdx.x == PROBE_BLK) st[k] = wall_clock64(); } } while (0)
    Unit cur, nxt; int ui = 0;
    if (!S.next(0, cur)) return;
    PG8_ST(0);
    typedef typename AccT<I8>::type acc_t; static_assert(!(I8 && HOOK), "no float hook on integer accumulators");
    acc_t acc[2][2][4][2];
#pragma unroll
    for (int a = 0; a < 2; ++a)
#pragma unroll
        for (int b = 0; b < 2; ++b)
#pragma unroll
            for (int m = 0; m < 4; ++m)
#pragma unroll
                for (int n = 0; n < 2; ++n) acc[a][b][m][n] = (acc_t){0, 0, 0, 0};
    bf16x8 At[4][2], B0[2][2], B1[2][2];
    const char* cA = (const char*)g.A + (size_t)cur.pm * tA + (size_t)(cur.pn >> g.a_shift) * g.a_stride; const char* cB = (const char*)g.Bt + (size_t)cur.pn * tB;
    if constexpr (SP2) {
        PG8_STAGE(PG8_SB(0, 0), cB, voffB); PG8_STAGE(PG8_SB(0, 1), cB + hB, voffB); PG8_STAGE(PG8_SA(0, 0), cA, voffA); PG8_STAGE(PG8_SA(0, 1), cA + hA, voffA);
        if (wr == 1) PG8_BAR;
        PG8_WAIT_V(2); PG8_BAR;
        PG8_STAGE(PG8_SB(1, 0), cB + kstep, voffB); PG8_STAGE(PG8_SA(1, 0), cA + kstep, voffA); PG8_STAGE(PG8_SB(1, 1), cB + hB + kstep, voffB);
        PG8_WAIT_V(6); PG8_BAR;
    } else {
        PG8_STAGE(PG8_SB(0, 0), cB, voffB); PG8_STAGE(PG8_SA(0, 0), cA, voffA); PG8_STAGE(PG8_SB(0, 1), cB + hB, voffB); PG8_STAGE(PG8_SA(0, 1), cA + hA, voffA);
        if (wr == 1) PG8_BAR;
        PG8_WAIT_V(4); PG8_BAR;
        PG8_STAGE(PG8_SB(1, 0), cB + kstep, voffB); PG8_STAGE(PG8_SA(1, 0), cA + kstep, voffA); PG8_STAGE(PG8_SB(1, 1), cB + hB + kstep, voffB);
        PG8_WAIT_V(6); PG8_BAR;
    }
    PG8_ST(1);
    for (;;) {
        const bool has_next = S.next(ui + 1, nxt);
        const char* nA = has_next ? (const char*)g.A + (size_t)nxt.pm * tA + (size_t)(nxt.pn >> g.a_shift) * g.a_stride : cA; const char* nB = has_next ? (const char*)g.Bt + (size_t)nxt.pn * tB : cB;
#pragma nounroll
        for (int t = 0; t < nt; t += 2) {
            const bool last = (t == nt - 2);
            if constexpr (HOOK) { if (t == (nt >> 1)) {
                float hsc[2][4];
#pragma unroll
                for (int a_ = 0; a_ < 2; ++a_)
#pragma unroll
                    for (int m_ = 0; m_ < 4; ++m_) hsc[a_][m_] = __builtin_amdgcn_rsqf((float)hss[cur.pm * 256 + a_ * 128 + wr * 64 + m_ * 16 + fr] * 2.3283064365386963e-10f * hinv + heps);
#pragma unroll
                for (int a_ = 0; a_ < 2; ++a_)
#pragma unroll
                    for (int b_ = 0; b_ < 2; ++b_)
#pragma unroll
                        for (int m_ = 0; m_ < 4; ++m_)
#pragma unroll
                            for (int n_ = 0; n_ < 2; ++n_) acc[a_][b_][m_][n_] *= hsc[a_][m_]; } }
            const char* a1 = cA + (size_t)(t + 1) * kstep;
            const char* a2 = last ? nA : cA + (size_t)(t + 2) * kstep; const char* b2 = last ? nB : cB + (size_t)(t + 2) * kstep;
            const char* a3 = a2 + kstep; const char* b3 = b2 + kstep;
            if constexpr (SP2) {
            PG8_LDB(B0, 0, 0); PG8_LDB(B1, 0, 1); PG8_SCHED; PG8_LDA(At, 0, 0); PG8_STAGE(PG8_SA(1, 1), a1 + hA, voffA);
            PG8_WAIT_V(8); PG8_WAIT_L(0); PG8_BAR; PG8_MMA(0, 0, At, B0); PG8_MMA(0, 1, At, B1); PG8_BAR; PG8_SCHED;
            PG8_LDA(At, 0, 1); PG8_STAGE(PG8_SB(0, 0), b2, voffB); PG8_STAGE(PG8_SB(0, 1), b2 + hB, voffB); PG8_STAGE(PG8_SA(0, 0), a2, voffA);
            PG8_WAIT_V(8); PG8_WAIT_L(0); PG8_BAR; PG8_MMA(1, 0, At, B0); PG8_MMA(1, 1, At, B1); PG8_BAR; PG8_SCHED;
            PG8_LDB(B0, 1, 0); PG8_LDB(B1, 1, 1); PG8_SCHED; PG8_LDA(At, 1, 0); PG8_STAGE(PG8_SA(0, 1), a2 + hA, voffA);
            PG8_WAIT_V(8); PG8_WAIT_L(0); PG8_BAR; PG8_MMA(0, 0, At, B0); PG8_MMA(0, 1, At, B1); PG8_BAR; PG8_SCHED;
            PG8_LDA(At, 1, 1); PG8_STAGE(PG8_SB(1, 0), b3, voffB); PG8_STAGE(PG8_SB(1, 1), b3 + hB, voffB); PG8_STAGE(PG8_SA(1, 0), a3, voffA);
            PG8_WAIT_V(8); PG8_WAIT_L(0); PG8_BAR; PG8_MMA(1, 0, At, B0); PG8_MMA(1, 1, At, B1); PG8_BAR; PG8_SCHED;
            } else {
            PG8_LDB(B0, 0, 0); PG8_SCHED; PG8_LDA(At, 0, 0); PG8_STAGE(PG8_SA(1, 1), a1 + hA, voffA);
            PG8_WAIT_L(8); PG8_BAR; PG8_WAIT_L(0); PG8_MMA(0, 0, At, B0); PG8_BAR; PG8_SCHED;
            PG8_LDB(B1, 0, 1); PG8_STAGE(PG8_SB(0, 0), b2, voffB);
            PG8_BAR; PG8_WAIT_L(0); PG8_MMA(0, 1, At, B1); PG8_BAR;
            PG8_LDA(At, 0, 1); PG8_STAGE(PG8_SA(0, 0), a2, voffA);
            PG8_BAR; PG8_WAIT_L(0); PG8_MMA(1, 0, At, B0); PG8_BAR; PG8_SCHED;
            PG8_STAGE(PG8_SB(0, 1), b2 + hB, voffB);
            PG8_WAIT_V(6); PG8_BAR; PG8_MMA(1, 1, At, B1); PG8_BAR;
            PG8_LDB(B0, 1, 0); PG8_SCHED; PG8_LDA(At, 1, 0); PG8_STAGE(PG8_SA(0, 1), a2 + hA, voffA);
            PG8_WAIT_L(8); PG8_BAR; PG8_WAIT_L(0); PG8_MMA(0, 0, At, B0); PG8_BAR; PG8_SCHED;
            PG8_LDB(B1, 1, 1); PG8_STAGE(PG8_SB(1, 0), b3, voffB);
            PG8_BAR; PG8_WAIT_L(0); PG8_MMA(0, 1, At, B1); PG8_BAR;
            PG8_LDA(At, 1, 1); PG8_STAGE(PG8_SA(1, 0), a3, voffA);
            PG8_BAR; PG8_WAIT_L(0); PG8_MMA(1, 0, At, B0); PG8_BAR; PG8_SCHED;
            PG8_STAGE(PG8_SB(1, 1), b3 + hB, voffB);
            PG8_WAIT_V(6); PG8_BAR; PG8_MMA(1, 1, At, B1); PG8_BAR;
            }
        }
        PG8_ST(2 + 2 * ui);
        if constexpr (ALIGN_EPI) { if (wr == 0) PG8_BAR; }
        E(acc, cur, wr, wc, fr, fq);
        PG8_ST(3 + 2 * ui);
        if (!has_next) break;
#pragma unroll
        for (int a = 0; a < 2; ++a)
#pragma unroll
            for (int b = 0; b < 2; ++b)
#pragma unroll
                for (int m = 0; m < 4; ++m)
#pragma unroll
                    for (int n = 0; n < 2; ++n) acc[a][b][m][n] = (acc_t){0, 0, 0, 0};
        cur = nxt; cA = nA; cB = nB; ++ui;
        if constexpr (ALIGN_EPI) { if (wr == 1) PG8_BAR; }
    }
    PG8_WAIT_V(0);
    if constexpr (!ALIGN_EPI) { if (wr == 0) PG8_BAR; }
    PG8_BAR;
#undef PG8_ST
#undef PG8_SA
#undef PG8_SB
#undef PG8_STAGE
#undef PG8_LDA
#undef PG8_LDB
#undef PG8_MMA
#undef PG8_WAIT_V
#undef PG8_WAIT_L
#undef PG8_BAR
#undef PG8_SCHED
}
}

constexpr int NWAVES = 8, NTHR = 512;
constexpr int D = 4096, FF = 11008, MX = 16384, MP = 16640, NPX = 64, NPP = 65;
constexpr int DR = 2048, DS = 2048, NG = 128, SL = 16  , NCHX = 1024, NCHP = 1040, UK = 384  ;
constexpr int NSEG = 32, SEGL = 128;
constexpr float EPS = 1e-6f;
constexpr int N_PHASES = 15;

constexpr size_t MiB = 1u << 20;
constexpr size_t CTL_ZERO_BYTES = 2 * MiB;
constexpr size_t al(size_t x) { return (x + MiB - 1) / MiB * MiB; }
constexpr size_t WS_CTL = 0;
constexpr size_t WS_W1GU = al(WS_CTL + CTL_ZERO_BYTES);
constexpr size_t WS_W1D  = al(WS_W1GU + (size_t)2 * FF * D * 2);
constexpr size_t WS_WIN  = al(WS_W1D + (size_t)D * FF * 2);
constexpr size_t WS_WRG  = al(WS_WIN + (size_t)6144 * D * 2);
constexpr size_t WS_WGLU = al(WS_WRG + (size_t)4096 * 256 * 2);
constexpr size_t WS_WOUT = al(WS_WGLU + (size_t)DS * DS * 2);
constexpr size_t WS_S5TQ = al(WS_WOUT + (size_t)D * D * 2);
constexpr size_t WS_S5P  = al(WS_S5TQ + (size_t)NG * 256 * UK * 2);
constexpr size_t WS_S5BB = al(WS_S5P + (size_t)NG * 256 * 256 * 2);
constexpr size_t WS_S5LAM = al(WS_S5BB + (size_t)NG * 64 * 16 * 2 * 4);
constexpr size_t WS_SEG  = al(WS_S5LAM + (size_t)NG * 64 * 4 * 4);
constexpr size_t WS_C8   = al(WS_SEG + (size_t)2 * 4 * NSEG * DR * 4);
constexpr size_t WS_SW   = al(WS_C8 + (size_t)DR * 4);
constexpr size_t WS_H0M  = al(WS_SW + MiB);
constexpr size_t WS_AX   = al(WS_H0M + (size_t)256 * D * 4);
constexpr size_t WS_AX2  = al(WS_AX + (size_t)MP * D * 2);
constexpr size_t WS_H    = al(WS_AX2 + (size_t)MP * D * 2);
constexpr size_t WS_HB   = al(WS_H + (size_t)MP * FF * 2);
constexpr size_t WS_END  = al(WS_HB + (size_t)MP * D * 2);
constexpr size_t WS_GG   = WS_H;
constexpr size_t WS_U    = al(WS_GG + (size_t)MP * DR * 2);
constexpr size_t WS_XCB  = al(WS_U + (size_t)NG * NCHP * UK * 2);
constexpr size_t WS_Z    = al(WS_XCB + (size_t)MP * DR * 2);
static_assert(WS_Z + (size_t)MX * DS * 2 <= WS_HB, "mixer overlays fit in H");
constexpr size_t DO_UA = 0, DO_URG = al((size_t)MP * DR * 2), DO_E = al(DO_URG + (size_t)MP * DR * 2);
static_assert(DO_E + (size_t)NG * NCHX * 128 * 4 <= (size_t)MX * D * 4, "d_out scratch");
constexpr int CW_BAR = 4096;
constexpr int CW_SS = 65536;
constexpr int CW_CM = CW_SS + 8 * MP + 64;
constexpr int CW_CMD = CW_CM + 4 * FF;
constexpr int CW_HM = CW_CMD + D;
static_assert((CW_HM + MX) * 4 <= (int)CTL_ZERO_BYTES && (CW_SS % 2) == 0, "ctl");

constexpr int RING_BYTES = 131072, MISC_OFF = RING_BYTES + 320, LDS_BYTES = 147456;

#define LAS __attribute__((address_space(3)))
typedef unsigned short bf16;
typedef unsigned v4u __attribute__((ext_vector_type(4)));
typedef unsigned v2u __attribute__((ext_vector_type(2)));
typedef float f32x4 __attribute__((ext_vector_type(4)));
typedef float f32x2 __attribute__((ext_vector_type(2)));
#define LDS_WAIT() asm volatile("s_waitcnt lgkmcnt(0)" ::: "memory")
#define VM_WAIT() asm volatile("s_waitcnt vmcnt(0)" ::: "memory")
using pg8::cvt_pk_bf16;
__device__ __forceinline__ float bf_lo(unsigned w) { return __uint_as_float(w << 16); }
__device__ __forceinline__ float bf_hi(unsigned w) { return __uint_as_float(w & 0xffff0000u); }
__device__ __forceinline__ float fsigmoid(float v) { return __builtin_amdgcn_rcpf(1.0f + __builtin_amdgcn_exp2f(-1.4426950408889634f * v)); }
__device__ __forceinline__ float gelu_tanh(float x) { const float u = x * (1.0f + 0.044715f * x * x); return x * fsigmoid(1.5957691216057308f * u); }
__device__ __forceinline__ float wave_sum(float v) {
#pragma unroll
    for (int o = 1; o < 64; o <<= 1) v += __shfl_xor(v, o);
    return v;
}

typedef unsigned long long u64;
__device__ __forceinline__ void ss_add(u64* p, float s) { atomicAdd(p, (u64)(s * 4294967296.0f)); }
__device__ __forceinline__ float ss_get(const u64* p) { return (float)(*p) * 2.3283064365386963e-10f; }

#define XB_TMO      128
#define XB_XCNT(j)  (256  + 64 * (j))
#define XB_XSUB(j)  (1280 + 64 * (j))
#define XB_XGEN(j)  (2304 + 64 * (j))
#define XB_TOP      3328
#define XB_TOPGEN   3392
#define XCD_BAR_WORDS 3456
#define XB_SPIN_CAP (1u << 18)
__device__ __forceinline__ unsigned xb_ld(unsigned* p)              { return __hip_atomic_load(p, __ATOMIC_RELAXED, __HIP_MEMORY_SCOPE_AGENT); }
__device__ __forceinline__ unsigned xb_add(unsigned* p, unsigned v) { return __hip_atomic_fetch_add(p, v, __ATOMIC_RELAXED, __HIP_MEMORY_SCOPE_AGENT); }
__device__ __forceinline__ unsigned xb_xcc_id() { return (unsigned)__builtin_amdgcn_s_getreg((3 << 11) | 20) & 0xFu; }
#define XB_SPIN(cond, bar) do { unsigned _sp = 0; while (cond) { __builtin_amdgcn_s_sleep(1); \
    if ((++_sp & 255u) == 0u) { if (xb_ld(&(bar)[XB_TMO])) break; if (_sp > XB_SPIN_CAP) { atomicAdd(&(bar)[XB_TMO], 1u); break; } } } } while (0)
struct XcdBarrier { unsigned* bar; unsigned x; volatile LAS unsigned* st; };
__device__ __forceinline__ XcdBarrier xcd_barrier_post(unsigned* bar, volatile LAS unsigned* st) {
    XcdBarrier b; b.bar = bar; b.x = xb_xcc_id(); b.st = st;
    if (threadIdx.x == 0) (void)xb_add(&bar[XB_XCNT(b.x)], 1u);
    return b;
}
__device__ __forceinline__ void xcd_barrier_complete(unsigned* bar, unsigned x, unsigned& nloc, unsigned& nx) {
    const unsigned G = gridDim.x * gridDim.y * gridDim.z;
    unsigned sum, cnt, mine, sp = 0u;
    for (;;) {
        sum = 0u; cnt = 0u; mine = 0u;
#pragma unroll
        for (unsigned j = 0; j < 16; ++j) { const unsigned c = xb_ld(&bar[XB_XCNT(j)]); sum += c; cnt += (c > 0u) ? 1u : 0u; mine = (j == x) ? c : mine; }
        if (sum == G) break;
        __builtin_amdgcn_s_sleep(1);
        if ((++sp & 255u) == 0u) { if (xb_ld(&bar[XB_TMO])) break; if (sp > XB_SPIN_CAP) { atomicAdd(&bar[XB_TMO], 1u); break; } }
    }
    nloc = mine > 0u ? mine : 1u; nx = cnt > 0u ? cnt : 1u;
}
__device__ __forceinline__ void xcd_barrier(const XcdBarrier& b) {
    asm volatile("s_waitcnt vmcnt(0)" ::: "memory");
    __syncthreads();
    if (threadIdx.x == 0) {
        unsigned* bar = b.bar;
        __builtin_amdgcn_s_waitcnt(0);
        unsigned nloc = b.st[0], nx = b.st[1];
        if (nloc == 0u) { xcd_barrier_complete(bar, b.x, nloc, nx); b.st[0] = nloc; b.st[1] = nx; }
        const unsigned old = xb_add(&bar[XB_XSUB(b.x)], 1u);
        const unsigned gen = old / nloc;
        if (old + 1u == (gen + 1u) * nloc) {
            __builtin_amdgcn_fence(__ATOMIC_RELEASE, "agent");
            asm volatile("s_waitcnt vmcnt(0)" ::: "memory");
            const unsigned og = xb_add(&bar[XB_TOP], 1u);
            const unsigned tg = og / nx;
            if (og + 1u == (tg + 1u) * nx) xb_add(&bar[XB_TOPGEN], 1u);
            else XB_SPIN(xb_ld(&bar[XB_TOPGEN]) == tg, bar);
            __builtin_amdgcn_fence(__ATOMIC_ACQUIRE, "agent");
            xb_add(&bar[XB_XGEN(b.x)], 1u);
            asm volatile("s_waitcnt vmcnt(0)" ::: "memory");
        } else {
            XB_SPIN(xb_ld(&bar[XB_XGEN(b.x)]) == gen, bar);
            __builtin_amdgcn_fence(__ATOMIC_ACQUIRE, "agent");
            asm volatile("s_waitcnt vmcnt(0)" ::: "memory");
        }
    }
    __syncthreads();
}

using pg8::Unit;
#define EPI_ARGS const f32x4 (&acc)[2][2][4][2], const Unit& u, int wr, int wc, int fr, int fq
#define ROWLOOP _Pragma("unroll") for (int ai = 0; ai < 2; ++ai) _Pragma("unroll") for (int m = 0; m < 4; ++m)

template <bool RS> struct EpiSwiglu {
    bf16* H; const u64* ss;
    __device__ __forceinline__ void operator()(EPI_ARGS) const {
        const int row0 = u.pm * 256 + wr * 64 + fr, j0 = u.pn * 128 + wc * 32 + 8 * fq;
        ROWLOOP { const int row = row0 + ai * 128 + m * 16;
            float rs = 1.0f; if (RS) rs = __builtin_amdgcn_rsqf(ss_get(ss + row) * (1.0f / D) + EPS);
            float h[8];
#pragma unroll
            for (int n = 0; n < 2; ++n)
#pragma unroll
                for (int e = 0; e < 4; ++e) { const float gv = acc[ai][0][m][n][e] * rs, uv = acc[ai][1][m][n][e] * rs; h[n * 4 + e] = gv * uv * fsigmoid(gv); }
            v4u w; w.x = cvt_pk_bf16(h[0], h[1]); w.y = cvt_pk_bf16(h[2], h[3]); w.z = cvt_pk_bf16(h[4], h[5]); w.w = cvt_pk_bf16(h[6], h[7]);
            *(v4u*)(H + (size_t)row * FF + j0) = w; }
    }
};
#define EPI_ARGS_I8 const pg8::i32x4 (&acc)[2][2][4][2], const Unit& u, int wr, int wc, int fr, int fq
template <bool RS> struct EpiSwigluI8 {
    bf16* H; const float* sa; const u64* ss; const float* sw; unsigned* hmax;
    __device__ __forceinline__ void operator()(EPI_ARGS_I8) const {
        const int row0 = u.pm * 256 + wr * 64 + fr, j0 = u.pn * 128 + wc * 32 + 8 * fq, b0 = u.pn * 256 + wc * 32 + 8 * fq;
        const f32x4 sg0 = *(const f32x4*)(sw + b0), sg1 = *(const f32x4*)(sw + b0 + 4), su0 = *(const f32x4*)(sw + b0 + 128), su1 = *(const f32x4*)(sw + b0 + 132);
        ROWLOOP { const int row = row0 + ai * 128 + m * 16;
            float rs = sa[row]; if (RS) rs *= __builtin_amdgcn_rsqf(ss_get(ss + row) * (1.0f / D) + EPS);
            float h[8];
#pragma unroll
            for (int e = 0; e < 4; ++e) { { const float gv = (float)acc[ai][0][m][0][e] * rs * sg0[e], uv = (float)acc[ai][1][m][0][e] * rs * su0[e]; h[e] = gv * uv * fsigmoid(gv); }
                                          { const float gv = (float)acc[ai][0][m][1][e] * rs * sg1[e], uv = (float)acc[ai][1][m][1][e] * rs * su1[e]; h[4 + e] = gv * uv * fsigmoid(gv); } }
            v4u w; w.x = cvt_pk_bf16(h[0], h[1]); w.y = cvt_pk_bf16(h[2], h[3]); w.z = cvt_pk_bf16(h[4], h[5]); w.w = cvt_pk_bf16(h[6], h[7]);
            *(v4u*)(H + (size_t)row * FF + j0) = w;
            if (hmax) { float mx = fmaxf(fmaxf(fmaxf(fabsf(h[0]), fabsf(h[1])), fmaxf(fabsf(h[2]), fabsf(h[3]))), fmaxf(fmaxf(fabsf(h[4]), fabsf(h[5])), fmaxf(fabsf(h[6]), fabsf(h[7]))));
                mx = fmaxf(mx, __shfl_xor(mx, 16)); mx = fmaxf(mx, __shfl_xor(mx, 32)); if (fq == 0) atomicMax(hmax + row, __float_as_uint(mx)); } }
    }
};
template <bool BASE_F32, bool FINAL> struct EpiResidB {
    const void* base; bf16* out; const float* gain; u64* ss;
    __device__ __forceinline__ void operator()(EPI_ARGS) const {
        const int row0 = u.pm * 256 + wr * 64 + fr;
        float sq[2][4];
        ROWLOOP sq[ai][m] = 0.f;
#pragma unroll
        for (int bj = 0; bj < 2; ++bj) { const int c0 = u.pn * 256 + bj * 128 + wc * 32 + 8 * fq;
            f32x4 g0 = {1.f, 1.f, 1.f, 1.f}, g1 = g0; if (FINAL) { g0 = *(const f32x4*)(gain + c0); g1 = *(const f32x4*)(gain + c0 + 4); }
#pragma unroll
            for (int ai = 0; ai < 2; ++ai) { f32x4 bq[4][2];
#pragma unroll
            for (int m = 0; m < 4; ++m) { const size_t off = (size_t)(row0 + ai * 128 + m * 16) * D + c0;
                if (BASE_F32) { bq[m][0] = *(const f32x4*)((const float*)base + off); bq[m][1] = *(const f32x4*)((const float*)base + off + 4); }
                else { const v4u w = *(const v4u*)((const bf16*)base + off); bq[m][0] = (f32x4){bf_lo(w.x), bf_hi(w.x), bf_lo(w.y), bf_hi(w.y)}; bq[m][1] = (f32x4){bf_lo(w.z), bf_hi(w.z), bf_lo(w.w), bf_hi(w.w)}; } }
#pragma unroll
            for (int m = 0; m < 4; ++m) { const size_t off = (size_t)(row0 + ai * 128 + m * 16) * D + c0;
                const f32x4 v0 = bq[m][0] + acc[ai][bj][m][0], v1 = bq[m][1] + acc[ai][bj][m][1];
                sq[ai][m] += (v0[0] * v0[0] + v0[1] * v0[1]) + (v0[2] * v0[2] + v0[3] * v0[3]) + (v1[0] * v1[0] + v1[1] * v1[1]) + (v1[2] * v1[2] + v1[3] * v1[3]);
                const f32x4 w0 = v0 * g0, w1 = v1 * g1;
                v4u w; w.x = cvt_pk_bf16(w0[0], w0[1]); w.y = cvt_pk_bf16(w0[2], w0[3]); w.z = cvt_pk_bf16(w1[0], w1[1]); w.w = cvt_pk_bf16(w1[2], w1[3]); *(v4u*)(out + off) = w; } } }
        ROWLOOP { float s = sq[ai][m]; s += __shfl_xor(s, 16); s += __shfl_xor(s, 32);
            if (fq == 0) ss_add(ss + row0 + ai * 128 + m * 16, s); }
    }
};
struct EpiResidI8 {
    const bf16* base; bf16* out; const float* gain; u64* ss; const float* sh; const float* sw;
    __device__ __forceinline__ void operator()(EPI_ARGS_I8) const {
        const int row0 = u.pm * 256 + wr * 64 + fr;
        float sq[2][4], rsc[2][4];
        ROWLOOP { sq[ai][m] = 0.f; rsc[ai][m] = sh[row0 + ai * 128 + m * 16]; }
#pragma unroll
        for (int bj = 0; bj < 2; ++bj) { const int c0 = u.pn * 256 + bj * 128 + wc * 32 + 8 * fq;
            const f32x4 g0 = *(const f32x4*)(gain + c0), g1 = *(const f32x4*)(gain + c0 + 4), s0 = *(const f32x4*)(sw + c0), s1 = *(const f32x4*)(sw + c0 + 4);
#pragma unroll
            for (int ai = 0; ai < 2; ++ai) { v4u bq[4];
#pragma unroll
            for (int m = 0; m < 4; ++m) bq[m] = *(const v4u*)(base + (size_t)(row0 + ai * 128 + m * 16) * D + c0);
#pragma unroll
            for (int m = 0; m < 4; ++m) { const size_t off = (size_t)(row0 + ai * 128 + m * 16) * D + c0; const v4u w = bq[m]; const float r = rsc[ai][m];
                const f32x4 b0 = {bf_lo(w.x), bf_hi(w.x), bf_lo(w.y), bf_hi(w.y)}, b1 = {bf_lo(w.z), bf_hi(w.z), bf_lo(w.w), bf_hi(w.w)};
                f32x4 v0, v1;
#pragma unroll
                for (int e = 0; e < 4; ++e) { v0[e] = b0[e] + (float)acc[ai][bj][m][0][e] * r * s0[e]; v1[e] = b1[e] + (float)acc[ai][bj][m][1][e] * r * s1[e]; }
                sq[ai][m] += (v0[0] * v0[0] + v0[1] * v0[1]) + (v0[2] * v0[2] + v0[3] * v0[3]) + (v1[0] * v1[0] + v1[1] * v1[1]) + (v1[2] * v1[2] + v1[3] * v1[3]);
                const f32x4 w0 = v0 * g0, w1 = v1 * g1;
                v4u o; o.x = cvt_pk_bf16(w0[0], w0[1]); o.y = cvt_pk_bf16(w0[2], w0[3]); o.z = cvt_pk_bf16(w1[0], w1[1]); o.w = cvt_pk_bf16(w1[2], w1[3]); *(v4u*)(out + off) = o; } } }
        ROWLOOP { float s = sq[ai][m]; s += __shfl_xor(s, 16); s += __shfl_xor(s, 32);
            if (fq == 0) ss_add(ss + row0 + ai * 128 + m * 16, s); }
    }
};
struct EpiWin {
    const u64* ss; bf16* urg; bf16* gg; bf16* U;
    __device__ __forceinline__ void operator()(EPI_ARGS) const {
        const int row0 = u.pm * 256 + wr * 64 + fr;
        ROWLOOP { const int row = row0 + ai * 128 + m * 16;
            const float rs = __builtin_amdgcn_rsqf(ss_get(ss + row) * (1.0f / D) + EPS);
#pragma unroll
            for (int bj = 0; bj < 2; ++bj) { const int c0 = u.pn * 256 + bj * 128 + wc * 32 + 8 * fq;
                const f32x4 v0 = acc[ai][bj][m][0] * rs, v1 = acc[ai][bj][m][1] * rs;
                if (u.pn < 8) { v4u w; w.x = cvt_pk_bf16(v0[0], v0[1]); w.y = cvt_pk_bf16(v0[2], v0[3]); w.z = cvt_pk_bf16(v1[0], v1[1]); w.w = cvt_pk_bf16(v1[2], v1[3]); *(v4u*)(urg + (size_t)row * DR + c0) = w; }
                else if (u.pn < 16) { v4u w; w.x = cvt_pk_bf16(gelu_tanh(v0[0]), gelu_tanh(v0[1])); w.y = cvt_pk_bf16(gelu_tanh(v0[2]), gelu_tanh(v0[3]));
                    w.z = cvt_pk_bf16(gelu_tanh(v1[0]), gelu_tanh(v1[1])); w.w = cvt_pk_bf16(gelu_tanh(v1[2]), gelu_tanh(v1[3])); *(v4u*)(gg + (size_t)row * DR + (c0 - 2048)) = w; }
                else { const int cs = c0 - 4096, g = cs >> 4, cp = cs & 15;
                    v4u w; w.x = cvt_pk_bf16(v0[0], v0[1]); w.y = cvt_pk_bf16(v0[2], v0[3]); w.z = cvt_pk_bf16(v1[0], v1[1]); w.w = cvt_pk_bf16(v1[2], v1[3]);
                    *(v4u*)(U + ((size_t)g * NCHP + (row >> 4)) * UK + (row & 15) * 16 + cp) = w; } } }
    }
};
__device__ __forceinline__ float one_minus_exp(float x) {
    const float big = 1.0f - __builtin_amdgcn_exp2f(1.4426950408889634f * x);
    const float small = -x * (1.0f + x * (0.5f + x * (0.16666667f + x * 0.041666668f)));
    return (x > -0.0625f) ? small : big;
}
struct EpiGates {
    const float* b_a; const float* b_x; const float* c8t; const bf16* xcb; bf16* LA; bf16* BX;
    __device__ __forceinline__ void operator()(EPI_ARGS) const {
        const int row0 = u.pm * 256 + wr * 64 + fr, ch0 = (u.pn >> 1) * 256 + (u.pn & 1) * 128 + wc * 32 + 8 * fq;
        const f32x4 ba0 = *(const f32x4*)(b_a + ch0), ba1 = *(const f32x4*)(b_a + ch0 + 4), bx0 = *(const f32x4*)(b_x + ch0), bx1 = *(const f32x4*)(b_x + ch0 + 4);
        const f32x4 c80 = *(const f32x4*)(c8t + ch0), c81 = *(const f32x4*)(c8t + ch0 + 4);
        v4u xq[2][4];
        ROWLOOP xq[ai][m] = *(const v4u*)(xcb + (size_t)(row0 + ai * 128 + m * 16) * DR + ch0);
        ROWLOOP { const size_t off = (size_t)(row0 + ai * 128 + m * 16) * DR + ch0; const v4u xw = xq[ai][m];
            const f32x4 x0 = {bf_lo(xw.x), bf_hi(xw.x), bf_lo(xw.y), bf_hi(xw.y)}, x1 = {bf_lo(xw.z), bf_hi(xw.z), bf_lo(xw.w), bf_hi(xw.w)};
            f32x4 l0, l1;
#pragma unroll
            for (int e = 0; e < 4; ++e) { l0[e] = c80[e] * fsigmoid(acc[ai][0][m][0][e] + ba0[e]); l1[e] = c81[e] * fsigmoid(acc[ai][0][m][1][e] + ba1[e]); }
            v4u lw; lw.x = cvt_pk_bf16(l0[0], l0[1]); lw.y = cvt_pk_bf16(l0[2], l0[3]); lw.z = cvt_pk_bf16(l1[0], l1[1]); lw.w = cvt_pk_bf16(l1[2], l1[3]);
            const f32x4 r0 = {bf_lo(lw.x), bf_hi(lw.x), bf_lo(lw.y), bf_hi(lw.y)}, r1 = {bf_lo(lw.z), bf_hi(lw.z), bf_lo(lw.w), bf_hi(lw.w)};
            f32x4 o0, o1;
#pragma unroll
            for (int e = 0; e < 4; ++e) { o0[e] = __builtin_amdgcn_sqrtf(one_minus_exp(2.0f * r0[e])) * fsigmoid(acc[ai][1][m][0][e] + bx0[e]) * x0[e];
                                          o1[e] = __builtin_amdgcn_sqrtf(one_minus_exp(2.0f * r1[e])) * fsigmoid(acc[ai][1][m][1][e] + bx1[e]) * x1[e]; }
            v4u ow; ow.x = cvt_pk_bf16(o0[0], o0[1]); ow.y = cvt_pk_bf16(o0[2], o0[3]); ow.z = cvt_pk_bf16(o1[0], o1[1]); ow.w = cvt_pk_bf16(o1[2], o1[3]);
            *(v4u*)(LA + off) = lw; *(v4u*)(BX + off) = ow; }
    }
};
struct EpiS5E {
    float* E;
    __device__ __forceinline__ void operator()(EPI_ARGS) const {
        const int row0 = u.pm * 256 + wr * 64 + fr, c0 = wc * 32 + 8 * fq;
        ROWLOOP { float* p = E + ((size_t)u.pn * NCHX + row0 + ai * 128 + m * 16) * 128 + c0; *(f32x4*)p = acc[ai][0][m][0]; *(f32x4*)(p + 4) = acc[ai][0][m][1]; }
    }
};
struct EpiS5Y {
    bf16* Z;
    __device__ __forceinline__ void operator()(EPI_ARGS) const {
        const int row0 = u.pm * 256 + wr * 64 + fr;
        ROWLOOP { const int j = row0 + ai * 128 + m * 16;
#pragma unroll
            for (int bj = 0; bj < 2; ++bj) { const int col = bj * 128 + wc * 32 + 8 * fq, t = col >> 4, cp = col & 15;
                const f32x4 v0 = acc[ai][bj][m][0], v1 = acc[ai][bj][m][1];
                v4u w; w.x = cvt_pk_bf16(gelu_tanh(v0[0]), gelu_tanh(v0[1])); w.y = cvt_pk_bf16(gelu_tanh(v0[2]), gelu_tanh(v0[3]));
                w.z = cvt_pk_bf16(gelu_tanh(v1[0]), gelu_tanh(v1[1])); w.w = cvt_pk_bf16(gelu_tanh(v1[2]), gelu_tanh(v1[3]));
                *(v4u*)(Z + (size_t)(j * 16 + t) * DS + u.pn * 16 + cp) = w; } }
    }
};
struct EpiGlu {
    const bf16* Z; const float* bias; const float* gain; bf16* AO; u64* ss;
    __device__ __forceinline__ void operator()(EPI_ARGS) const {
        const int row0 = u.pm * 256 + wr * 64 + fr;
        float sq[2][4];
        ROWLOOP sq[ai][m] = 0.f;
#pragma unroll
        for (int bj = 0; bj < 2; ++bj) { const int c0 = u.pn * 256 + bj * 128 + wc * 32 + 8 * fq;
            const f32x4 b0 = *(const f32x4*)(bias + c0), b1 = *(const f32x4*)(bias + c0 + 4), g0 = *(const f32x4*)(gain + c0), g1 = *(const f32x4*)(gain + c0 + 4);
            v4u zq[2][4];
            ROWLOOP zq[ai][m] = *(const v4u*)(Z + (size_t)(row0 + ai * 128 + m * 16) * DS + c0);
            ROWLOOP { const int row = row0 + ai * 128 + m * 16;
                const v4u zw = zq[ai][m];
                const f32x4 z0 = {bf_lo(zw.x), bf_hi(zw.x), bf_lo(zw.y), bf_hi(zw.y)}, z1 = {bf_lo(zw.z), bf_hi(zw.z), bf_lo(zw.w), bf_hi(zw.w)};
                f32x4 y0, y1;
#pragma unroll
                for (int e = 0; e < 4; ++e) { y0[e] = z0[e] * fsigmoid(acc[ai][bj][m][0][e] + b0[e]); y1[e] = z1[e] * fsigmoid(acc[ai][bj][m][1][e] + b1[e]); }
                sq[ai][m] += (y0[0] * y0[0] + y0[1] * y0[1]) + (y0[2] * y0[2] + y0[3] * y0[3]) + (y1[0] * y1[0] + y1[1] * y1[1]) + (y1[2] * y1[2] + y1[3] * y1[3]);
                const f32x4 w0 = y0 * g0, w1 = y1 * g1;
                v4u w; w.x = cvt_pk_bf16(w0[0], w0[1]); w.y = cvt_pk_bf16(w0[2], w0[3]); w.z = cvt_pk_bf16(w1[0], w1[1]); w.w = cvt_pk_bf16(w1[2], w1[3]);
                *(v4u*)(AO + (size_t)row * D + c0) = w; } }
        ROWLOOP { float s = sq[ai][m]; s += __shfl_xor(s, 16); s += __shfl_xor(s, 32);
            if (fq == 0) ss_add(ss + row0 + ai * 128 + m * 16, s); }
    }
};

struct Args { const float* in[33]; float* out; unsigned char* ws; int ph_lo, ph_hi; };
enum { I_X = 0, I_META, I_N1, I_WG1, I_WU1, I_WD1, I_NMIX, I_WIN, I_CONVW, I_CONVB, I_WA, I_BA, I_WX, I_BX, I_LAM, I_S5LRE, I_S5LIM, I_S5LDT, I_S5BRE, I_S5BIM, I_S5CRE, I_S5CIM,
       I_S5D, I_GLUW, I_GLUB, I_NRG, I_NS5, I_WOUT, I_N2, I_WG2, I_WU2, I_WD2, I_NFIN };

struct CvtJob { const float* W; int N; bf16* WT; int ldk, k0, n0, dest_row0; const float* gk; float wscale; };
__device__ __forceinline__ void cvt_load(const CvtJob& j, float (&v)[32], int lane) {
#pragma unroll
    for (int i = 0; i < 32; ++i) v[i] = j.W[(size_t)(j.k0 + 2 * i + (lane >> 5)) * j.N + j.n0 + (lane & 31)];
    if (j.gk) {
#pragma unroll
        for (int i = 0; i < 32; ++i) v[i] *= j.gk[2 * i + (lane >> 5)]; }
    if (j.wscale != 1.0f) {
#pragma unroll
        for (int i = 0; i < 32; ++i) v[i] *= j.wscale; }
}
__device__ __forceinline__ void cvt_to_lds(const float (&v)[32], LAS float* scr, int lane) {
#pragma unroll
    for (int i = 0; i < 32; ++i) scr[(2 * i + (lane >> 5)) * 33 + (lane & 31)] = v[i];
}
__device__ __forceinline__ void cvt_store(const CvtJob& j, LAS float* scr, int lane) {
    LDS_WAIT(); asm volatile("" ::: "memory");
    const int c = lane & 7;
#pragma unroll
    for (int q = 0; q < 4; ++q) { const int n = (lane >> 3) + 8 * q; const LAS float* s = scr + (8 * c) * 33 + n;
        v4u o; o.x = cvt_pk_bf16(s[0 * 33], s[1 * 33]); o.y = cvt_pk_bf16(s[2 * 33], s[3 * 33]); o.z = cvt_pk_bf16(s[4 * 33], s[5 * 33]); o.w = cvt_pk_bf16(s[6 * 33], s[7 * 33]);
        *(v4u*)(j.WT + (size_t)(j.dest_row0 + n) * j.ldk + j.k0 + 8 * c) = o; }
    LDS_WAIT(); asm volatile("" ::: "memory");
}
template <int MODE> __device__ __forceinline__ CvtJob cvt_job(const float* W, int K, int N, bf16* WT, int it, const float* gk, float wscale) {
    const int nblk = N / 32, kb = it / nblk, nb = it % nblk, k0 = kb * 64, n0 = nb * 32; const float* g = gk ? gk + k0 : nullptr;
    if (MODE == 3) return CvtJob{W + (size_t)k0 * N, N, WT + (k0 + K / 2) % K, K, 0, n0, n0, g, wscale};
    if (MODE == 0) return CvtJob{W, N, WT, K, k0, n0, n0, g, wscale};
    return CvtJob{W, N, WT, K, k0, n0, (n0 >> 7) * 256 + (MODE - 1) * 128 + (n0 & 127), g, wscale};
}
template <int MODE> __device__ __forceinline__ void cvt_matrix(const float* W, int K, int N, bf16* WT, LAS float* scr, int gw, int NGW, int lane, const float* gk = nullptr, float wscale = 1.0f) {
    const int nit = (K / 64) * (N / 32);
    int it = gw; if (it >= nit) return;
    float v[32]; CvtJob cur = cvt_job<MODE>(W, K, N, WT, it, gk, wscale); cvt_load(cur, v, lane);
    for (;;) {
        cvt_to_lds(v, scr, lane);
        const int nx = it + NGW; const bool more = nx < nit; CvtJob nxt = cur;
        if (more) { nxt = cvt_job<MODE>(W, K, N, WT, nx, gk, wscale); cvt_load(nxt, v, lane); }
        cvt_store(cur, scr, lane);
        if (!more) break;
        it = nx; cur = nxt;
    }
}
__device__ __forceinline__ void cvt_item(const float* W, int N, bf16* WT, int ldk, int k0, int n0, int dest_row0, LAS float* scr, int lane) {
    const CvtJob j{W, N, WT, ldk, k0, n0, dest_row0, nullptr, 1.0f}; float v[32]; cvt_load(j, v, lane); cvt_to_lds(v, scr, lane); cvt_store(j, scr, lane);
}

__device__ __forceinline__ int q127(float v) { return __float2int_rn(__builtin_amdgcn_fmed3f(v, -127.0f, 127.0f)); }
__device__ __forceinline__ unsigned pack_i8x4(float a, float b, float c, float d) {
    return ((unsigned)q127(a) & 255u) | (((unsigned)q127(b) & 255u) << 8) | (((unsigned)q127(c) & 255u) << 16) | ((unsigned)q127(d) << 24); }
__device__ __forceinline__ void colmax_matrix(const float* W, int K, int N, const float* gk, unsigned* cm, int gw, int NGW, int lane) {
    const int nblk = N / 256, nit = (K / 64) * nblk;
    for (int it = gw; it < nit; it += NGW) { const int kb = it / nblk, nb = it % nblk, n = nb * 256 + 4 * lane; f32x4 mx = {0.f, 0.f, 0.f, 0.f};
        for (int k0 = kb * 64; k0 < kb * 64 + 64; k0 += 16) { f32x4 v[16];
#pragma unroll
            for (int j = 0; j < 16; ++j) v[j] = *(const f32x4*)(W + (size_t)(k0 + j) * N + n);
#pragma unroll
            for (int j = 0; j < 16; ++j) { const float gg = gk ? gk[k0 + j] : 1.0f;
#pragma unroll
                for (int e = 0; e < 4; ++e) mx[e] = fmaxf(mx[e], fabsf(v[j][e] * gg)); } }
#pragma unroll
        for (int e = 0; e < 4; ++e) atomicMax(cm + n + e, __float_as_uint(mx[e])); }
}
__device__ __forceinline__ void quant_gu_matrix(const float* W, int K, int N, const float* gk, const unsigned* cm, unsigned char* WT, float* sw, int half_gu, LAS unsigned* scr, int gw, int NGW, int lane, float sscale = 1.0f) {
    const int nblk = N / 32, nit = (K / 128) * nblk, hl = lane >> 5, nl = lane & 31;
    for (int it = gw; it < nit; it += NGW) { const int kb = it / nblk, nb = it % nblk, k0 = kb * 128, n0 = nb * 32, drow0 = (half_gu < 0) ? n0 : (n0 >> 7) * 256 + half_gu * 128 + (n0 & 127);
        const float cmx = __uint_as_float(cm[n0 + nl]), inv = cmx > 0.f ? 127.0f / cmx : 0.f;
        if (kb == 0 && hl == 0) sw[drow0 + nl] = cmx * (sscale / 127.0f);
        float v[16][4];
#pragma unroll
        for (int j = 0; j < 16; ++j)
#pragma unroll
            for (int e = 0; e < 4; ++e) v[j][e] = W[(size_t)(k0 + 8 * j + 4 * hl + e) * N + n0 + nl];
        if (gk) {
#pragma unroll
            for (int j = 0; j < 16; ++j)
#pragma unroll
                for (int e = 0; e < 4; ++e) v[j][e] *= gk[k0 + 8 * j + 4 * hl + e]; }
#pragma unroll
        for (int j = 0; j < 16; ++j) scr[nl * 33 + 2 * j + hl] = pack_i8x4(v[j][0] * inv, v[j][1] * inv, v[j][2] * inv, v[j][3] * inv);
        LDS_WAIT(); asm volatile("" ::: "memory");
#pragma unroll
        for (int q = 0; q < 4; ++q) { const int r = (lane >> 3) + 8 * q, pc = lane & 7; const LAS unsigned* sp = scr + r * 33 + 4 * pc;
            v4u o; o.x = sp[0]; o.y = sp[1]; o.z = sp[2]; o.w = sp[3];
            *(v4u*)(WT + (size_t)(drow0 + r) * K + k0 + 16 * pc) = o; }
        LDS_WAIT(); asm volatile("" ::: "memory"); }
}

struct Ctx { LAS unsigned char* lds; int wave, vcu, G; };
#define PHASE_IDS const int lane_ = pg8::lane_id_opaque(); const int tid_ = F.wave * 64 + lane_;

__device__ __forceinline__ void s5_tables(const Args& a, const Ctx& F, int g, int hv) {
    PHASE_IDS
    LAS f32x2* pw = (LAS f32x2*)(F.lds);
    LAS f32x2* bb = (LAS f32x2*)(F.lds + 8704);
    LAS f32x2* cc = (LAS f32x2*)(F.lds + 8704 + 8192);
    LAS float* Kt = (LAS float*)(F.lds + 8704 + 16384);
    LAS f32x2* qn = (LAS f32x2*)(F.lds + 8704 + 32768);
    const float dt = expf(a.in[I_S5LDT][g]);
    const float* lre = a.in[I_S5LRE] + g * 64; const float* lim = a.in[I_S5LIM] + g * 64;
    float* BBg = (float*)(a.ws + WS_S5BB); float* LAMg = (float*)(a.ws + WS_S5LAM);
    if (tid_ < 64) { const int n = tid_; const float x = lre[n] * dt, th = lim[n] * dt, mag = expf(x), e1 = expm1f(x); float sn, co; sincosf(th, &sn, &co); const float sh = sinf(0.5f * th);
        const float lr = mag * co, li = mag * sn; float pr = 1.f, pi = 0.f;
#pragma unroll
        for (int tau = 0; tau <= 16; ++tau) { pw[tau * 64 + n] = (f32x2){pr, pi}; if (tau == 1 && hv == 0) { LAMg[(size_t)(g * 64 + n) * 4] = pr; LAMg[(size_t)(g * 64 + n) * 4 + 1] = pi; }
            if (tau == 16 && hv == 0) { LAMg[(size_t)(g * 64 + n) * 4 + 2] = pr; LAMg[(size_t)(g * 64 + n) * 4 + 3] = pi; }
            const float nr = pr * lr - pi * li, ni = pr * li + pi * lr; pr = nr; pi = ni; }
        const float nr = e1 * co - 2.0f * sh * sh, ni = (e1 + 1.0f) * sn;
        const float ar = lre[n], ai = lim[n], den = 1.0f / (ar * ar + ai * ai);
        qn[n] = (f32x2){(nr * ar + ni * ai) * den, (ni * ar - nr * ai) * den}; }
    for (int idx = tid_; idx < 16 * 64; idx += NTHR) { const int c = idx >> 6, n = idx & 63; cc[idx] = (f32x2){a.in[I_S5CRE][(g * 16 + c) * 64 + n], a.in[I_S5CIM][(g * 16 + c) * 64 + n]}; }
    __syncthreads();
    for (int idx = tid_; idx < 64 * 16; idx += NTHR) { const int n = idx >> 4, c = idx & 15; const f32x2 q = qn[n];
        const float br = a.in[I_S5BRE][(g * 64 + n) * 16 + c], bi = a.in[I_S5BIM][(g * 64 + n) * 16 + c];
        const f32x2 v = {q.x * br - q.y * bi, q.x * bi + q.y * br};
        bb[idx] = v; if (hv == 0) *(f32x2*)(BBg + ((size_t)(g * 64 + n) * 16 + c) * 2) = v; }
    __syncthreads();
    { const int tau = tid_ >> 5, c = 8 * hv + ((tid_ >> 2) & 7), cq = tid_ & 3; float k4[4] = {0.f, 0.f, 0.f, 0.f};
        for (int n = 0; n < 64; ++n) { const f32x2 C = cc[c * 64 + n], P = pw[tau * 64 + n]; const float qr = C.x * P.x - C.y * P.y, qi = C.x * P.y + C.y * P.x;
#pragma unroll
            for (int e = 0; e < 4; ++e) { const f32x2 B = bb[n * 16 + 4 * cq + e]; k4[e] += qr * B.x - qi * B.y; } }
#pragma unroll
        for (int e = 0; e < 4; ++e) { if (tau == 0 && c == 4 * cq + e) k4[e] += a.in[I_S5D][g * 16 + c]; Kt[(tau * 16 + c) * 16 + 4 * cq + e] = k4[e]; } }
    __syncthreads();
    bf16* TQ = (bf16*)(a.ws + WS_S5TQ) + (size_t)g * 256 * UK; bf16* PP = (bf16*)(a.ws + WS_S5P) + (size_t)g * 256 * 256;
    for (int idx = tid_; idx < 128 * 48; idx += NTHR) { const int rr = idx / 48, kc = idx % 48, t = rr >> 3, c = 8 * hv + (rr & 7), rho = t * 16 + c; float v[8];
        if (kc < 32) { const int sx = kc >> 1, cp0 = (kc & 1) * 8;
#pragma unroll
            for (int e = 0; e < 8; ++e) v[e] = (t >= sx) ? Kt[((t - sx) * 16 + c) * 16 + cp0 + e] : 0.f; }
        else { const int n0 = (kc - 32) * 4;
#pragma unroll
            for (int e = 0; e < 4; ++e) { const f32x2 C = cc[c * 64 + n0 + e], P = pw[(t + 1) * 64 + n0 + e]; v[2 * e] = C.x * P.x - C.y * P.y; v[2 * e + 1] = -(C.x * P.y + C.y * P.x); } }
        v4u w; w.x = cvt_pk_bf16(v[0], v[1]); w.y = cvt_pk_bf16(v[2], v[3]); w.z = cvt_pk_bf16(v[4], v[5]); w.w = cvt_pk_bf16(v[6], v[7]);
        *(v4u*)(TQ + (size_t)rho * UK + kc * 8) = w; }
    for (int idx = tid_; idx < 128 * 32; idx += NTHR) { const int rr = idx >> 5, kc = idx & 31, sx = kc >> 1, cp0 = (kc & 1) * 8; float v[8];
#pragma unroll
        for (int e = 0; e < 8; ++e) v[e] = 0.f;
        const int rho = (rr < 64) ? 64 * hv + rr : 128 + 64 * hv + (rr - 64);
        if (rr < 64) { const int n = rho >> 1; const f32x2 P = pw[(15 - sx) * 64 + n];
#pragma unroll
            for (int e = 0; e < 8; ++e) { const f32x2 B = bb[n * 16 + cp0 + e]; v[e] = (rho & 1) ? (P.x * B.y + P.y * B.x) : (P.x * B.x - P.y * B.y); } }
        v4u w; w.x = cvt_pk_bf16(v[0], v[1]); w.y = cvt_pk_bf16(v[2], v[3]); w.z = cvt_pk_bf16(v[4], v[5]); w.w = cvt_pk_bf16(v[6], v[7]);
        *(v4u*)(PP + (size_t)rho * 256 + kc * 8) = w; }
    __syncthreads();
}

__device__ __forceinline__ void p0_prologue(const Args& a, const Ctx& F) {
    PHASE_IDS
    if (PROBE_SPIN == 21 && blockIdx.x == 0 && threadIdx.x == 0) ((unsigned long long*)((unsigned*)(a.ws + WS_CTL) + 3000))[21] = wall_clock64();
    for (int j = F.vcu; j < 2 * NG; j += F.G) s5_tables(a, F, j & (NG - 1), j >> 7);
    if (PROBE_SPIN == 21 && blockIdx.x == 0 && threadIdx.x == 0) ((unsigned long long*)((unsigned*)(a.ws + WS_CTL) + 3000))[22] = wall_clock64();
    LAS float* scr = (LAS float*)(F.lds + F.wave * 16384);
    const int gw = F.vcu * NWAVES + F.wave, NGW = F.G * NWAVES;
    colmax_matrix(a.in[I_WG1], D, FF, nullptr, (unsigned*)(a.ws + WS_CTL) + CW_CM, gw, NGW, lane_);
    colmax_matrix(a.in[I_WU1], D, FF, nullptr, (unsigned*)(a.ws + WS_CTL) + CW_CM + FF, gw, NGW, lane_);
    cvt_matrix<0>(a.in[I_WD1], FF, D, (bf16*)(a.ws + WS_W1D), scr, gw, NGW, lane_, nullptr, 0.5f);
    cvt_matrix<0>(a.in[I_WIN], D, 6144, (bf16*)(a.ws + WS_WIN), scr, gw, NGW, lane_, a.in[I_NMIX], 1.0f);
    cvt_matrix<0>(a.in[I_GLUW], DS, DS, (bf16*)(a.ws + WS_WGLU), scr, gw, NGW, lane_);
    cvt_matrix<3>(a.in[I_WOUT], D, D, (bf16*)(a.ws + WS_WOUT), scr, gw, NGW, lane_);
    for (int it = gw; it < 512; it += NGW) { const int h = it >> 6, which = (it >> 5) & 1, kb = (it >> 3) & 3, nb = it & 7, n0 = nb * 32;
        cvt_item(a.in[which ? I_WX : I_WA] + (size_t)h * 65536, 256, (bf16*)(a.ws + WS_WRG), 256, kb * 64, n0, (h * 2 + (n0 >> 7)) * 256 + which * 128 + (n0 & 127), scr, lane_); }
    for (int i = F.vcu * NTHR + tid_; i < DR; i += F.G * NTHR) ((float*)(a.ws + WS_C8))[i] = -8.0f * log1pf(expf(-a.in[I_LAM][i]));
    unsigned char* A1 = (unsigned char*)(a.ws + WS_AX); float* SA1 = (float*)(a.ws + WS_SW + 131072); float* H0M = (float*)(a.ws + WS_H0M); const float* g1 = a.in[I_N1];
    for (int m = gw; m < MP; m += NGW) {
        f32x4 v[16];
        if (m < MX + 16) { const float* src = (m < MX) ? a.in[I_X] + (size_t)m * D : a.in[I_META] + (size_t)(m - MX) * D;
#pragma unroll
            for (int j = 0; j < 16; ++j) v[j] = *(const f32x4*)(src + 4 * lane_ + 256 * j); }
        else {
#pragma unroll
            for (int j = 0; j < 16; ++j) v[j] = (f32x4){0.f, 0.f, 0.f, 0.f}; }
        if (m >= MX) {
#pragma unroll
            for (int j = 0; j < 16; ++j) *(f32x4*)(H0M + (size_t)(m - MX) * D + 4 * lane_ + 256 * j) = v[j]; }
        float s = 0.f;
#pragma unroll
        for (int j = 0; j < 16; ++j) s += (v[j][0] * v[j][0] + v[j][1] * v[j][1]) + (v[j][2] * v[j][2] + v[j][3] * v[j][3]);
        const float rs = __builtin_amdgcn_rsqf(wave_sum(s) * (1.0f / D) + EPS);
        float mx = 0.f;
#pragma unroll
        for (int j = 0; j < 16; ++j) { v[j] = v[j] * rs * *(const f32x4*)(g1 + 4 * lane_ + 256 * j);
            mx = fmaxf(fmaxf(mx, fmaxf(fabsf(v[j][0]), fabsf(v[j][1]))), fmaxf(fabsf(v[j][2]), fabsf(v[j][3]))); }
#pragma unroll
        for (int o = 1; o < 64; o <<= 1) mx = fmaxf(mx, __shfl_xor(mx, o));
        const float inv = mx > 0.f ? 127.0f / mx : 0.f;
        if (lane_ == 0) SA1[m] = mx * (1.0f / 127.0f);
#pragma unroll
        for (int j = 0; j < 16; ++j) *(unsigned*)(A1 + (size_t)m * D + 4 * lane_ + 256 * j) = pack_i8x4(v[j][0] * inv, v[j][1] * inv, v[j][2] * inv, v[j][3] * inv);
    }
}

__device__ __forceinline__ void p8_quant_w2(const Args& a, const Ctx& F) {
    PHASE_IDS
    LAS unsigned* scr = (LAS unsigned*)(F.lds + F.wave * 8192);
    const int gw = F.vcu * NWAVES + F.wave, NGW = F.G * NWAVES; const unsigned* cm = (const unsigned*)(a.ws + WS_CTL) + CW_CM + 2 * FF;
    quant_gu_matrix(a.in[I_WG2], D, FF, a.in[I_N2], cm, (unsigned char*)(a.ws + WS_W1GU), (float*)(a.ws + WS_SW), 0, scr, gw, NGW, lane_);
    quant_gu_matrix(a.in[I_WU2], D, FF, a.in[I_N2], cm + FF, (unsigned char*)(a.ws + WS_W1GU), (float*)(a.ws + WS_SW), 1, scr, gw, NGW, lane_);
    quant_gu_matrix(a.in[I_WD2], FF, D, nullptr, (const unsigned*)(a.ws + WS_CTL) + CW_CMD, (unsigned char*)(a.ws + WS_W1D), (float*)(a.ws + WS_SW + 262144), -1, scr, gw, NGW, lane_, 0.5f);
}
__device__ __forceinline__ void p10_quant_h2(const Args& a, const Ctx& F) {
    PHASE_IDS
    const bf16* HB = (const bf16*)(a.ws + WS_HB); unsigned char* A2 = (unsigned char*)(a.ws + WS_AX); float* SA2 = (float*)(a.ws + WS_SW + 131072);
    const u64* ss2 = (const u64*)((const unsigned*)(a.ws + WS_CTL) + CW_SS) + MP;
    const int gw = F.vcu * NWAVES + F.wave, NGW = F.G * NWAVES;
    for (int m = gw; m < MX; m += NGW) { v4u w[8]; float mx = 0.f;
#pragma unroll
        for (int j = 0; j < 8; ++j) w[j] = *(const v4u*)(HB + (size_t)m * D + 8 * lane_ + 512 * j);
#pragma unroll
        for (int j = 0; j < 8; ++j) { mx = fmaxf(fmaxf(mx, fmaxf(fabsf(bf_lo(w[j].x)), fabsf(bf_hi(w[j].x)))), fmaxf(fabsf(bf_lo(w[j].y)), fabsf(bf_hi(w[j].y))));
                                      mx = fmaxf(fmaxf(mx, fmaxf(fabsf(bf_lo(w[j].z)), fabsf(bf_hi(w[j].z)))), fmaxf(fabsf(bf_lo(w[j].w)), fabsf(bf_hi(w[j].w)))); }
#pragma unroll
        for (int o = 1; o < 64; o <<= 1) mx = fmaxf(mx, __shfl_xor(mx, o));
        const float inv = mx > 0.f ? 127.0f / mx : 0.f;
        if (lane_ == 0) SA2[m] = mx * (1.0f / 127.0f) * __builtin_amdgcn_rsqf(ss_get(ss2 + m) * (1.0f / D) + EPS);
#pragma unroll
        for (int j = 0; j < 8; ++j) { v2u q; q.x = pack_i8x4(bf_lo(w[j].x) * inv, bf_hi(w[j].x) * inv, bf_lo(w[j].y) * inv, bf_hi(w[j].y) * inv);
            q.y = pack_i8x4(bf_lo(w[j].z) * inv, bf_hi(w[j].z) * inv, bf_lo(w[j].w) * inv, bf_hi(w[j].w) * inv); *(v2u*)(A2 + (size_t)m * D + 8 * lane_ + 512 * j) = q; } }
}

__device__ __forceinline__ void p12_quant_h(const Args& a, const Ctx& F) {
    PHASE_IDS
    const bf16* H = (const bf16*)(a.ws + WS_H); unsigned char* Hq = (unsigned char*)(a.ws + WS_AX); float* SH = (float*)(a.ws + WS_SW + 393216);
    LAS float* xm = (LAS float*)F.lds;
    const int pair = F.wave >> 1, hf = F.wave & 1, NP = F.G * 4;
    int it = 0;
    for (int m = F.vcu * 4 + pair; m < MX; m += NP, ++it) {
        v4u w[11]; float mx = 0.f;
#pragma unroll
        for (int j = 0; j < 11; ++j) { const int ch = lane_ + 64 * (j + 11 * hf); w[j] = (ch < FF / 8) ? *(const v4u*)(H + (size_t)m * FF + 8 * ch) : (v4u){0u, 0u, 0u, 0u}; }
#pragma unroll
        for (int j = 0; j < 11; ++j) { mx = fmaxf(fmaxf(mx, fmaxf(fabsf(bf_lo(w[j].x)), fabsf(bf_hi(w[j].x)))), fmaxf(fabsf(bf_lo(w[j].y)), fabsf(bf_hi(w[j].y))));
                                       mx = fmaxf(fmaxf(mx, fmaxf(fabsf(bf_lo(w[j].z)), fabsf(bf_hi(w[j].z)))), fmaxf(fabsf(bf_lo(w[j].w)), fabsf(bf_hi(w[j].w)))); }
#pragma unroll
        for (int o = 1; o < 64; o <<= 1) mx = fmaxf(mx, __shfl_xor(mx, o));
        if (lane_ == 0) xm[(it & 1) * 8 + F.wave] = mx;
        __syncthreads();
        mx = fmaxf(mx, xm[(it & 1) * 8 + (F.wave ^ 1)]);
        const float inv = mx > 0.f ? 127.0f / mx : 0.f;
        if (lane_ == 0 && hf == 0) SH[m] = mx * (1.0f / 127.0f);
#pragma unroll
        for (int j = 0; j < 11; ++j) { const int ch = lane_ + 64 * (j + 11 * hf);
            if (ch < FF / 8) { v2u q; q.x = pack_i8x4(bf_lo(w[j].x) * inv, bf_hi(w[j].x) * inv, bf_lo(w[j].y) * inv, bf_hi(w[j].y) * inv);
                q.y = pack_i8x4(bf_lo(w[j].z) * inv, bf_hi(w[j].z) * inv, bf_lo(w[j].w) * inv, bf_hi(w[j].w) * inv); *(v2u*)(Hq + (size_t)m * FF + 8 * ch) = q; } } }
    __syncthreads();
}

__device__ __forceinline__ void p1_quant_w1(const Args& a, const Ctx& F) {
    PHASE_IDS
    LAS unsigned* scr = (LAS unsigned*)(F.lds + F.wave * 8192);
    const int gw = F.vcu * NWAVES + F.wave, NGW = F.G * NWAVES; const unsigned* cm = (const unsigned*)(a.ws + WS_CTL) + CW_CM;
    quant_gu_matrix(a.in[I_WG1], D, FF, nullptr, cm, (unsigned char*)(a.ws + WS_W1GU), (float*)(a.ws + WS_SW), 0, scr, gw, NGW, lane_);
    quant_gu_matrix(a.in[I_WU1], D, FF, nullptr, cm + FF, (unsigned char*)(a.ws + WS_W1GU), (float*)(a.ws + WS_SW), 1, scr, gw, NGW, lane_);
}

__device__ __forceinline__ void p4_conv(const Args& a, const Ctx& F) {
    PHASE_IDS
    const bf16* ur = (const bf16*)((const char*)a.out + DO_URG); bf16* xcb = (bf16*)(a.ws + WS_XCB);
    const float* cw = a.in[I_CONVW]; const float* cb = a.in[I_CONVB];
    for (int idx = F.vcu * NTHR + tid_; idx < (MP / 8) * 512; idx += F.G * NTHR) { const int row0 = (idx >> 9) * 8, c4 = (idx & 511) * 4;
        const f32x4 bias = *(const f32x4*)(cb + c4), w0 = *(const f32x4*)(cw + c4), w1 = *(const f32x4*)(cw + DR + c4), w2 = *(const f32x4*)(cw + 2 * DR + c4), w3 = *(const f32x4*)(cw + 3 * DR + c4);
        f32x4 uu[11];
#pragma unroll
        for (int j = 0; j < 11; ++j) { const int r = row0 - 3 + j; int srow;
            if (row0 < MX) srow = (j >= 3) ? r : (((row0 & 4095) != 0) ? r : MX + 13 + j);
            else srow = (j >= 3 || row0 > MX) ? r : -1;
            if (srow >= 0) { const v2u w = *(const v2u*)(ur + (size_t)srow * DR + c4); uu[j] = (f32x4){bf_lo(w.x), bf_hi(w.x), bf_lo(w.y), bf_hi(w.y)}; } else uu[j] = (f32x4){0.f, 0.f, 0.f, 0.f}; }
#pragma unroll
        for (int j = 0; j < 8; ++j) { const f32x4 sv = bias + w0 * uu[j] + w1 * uu[j + 1] + w2 * uu[j + 2] + w3 * uu[j + 3];
            v2u w; w.x = cvt_pk_bf16(sv[0], sv[1]); w.y = cvt_pk_bf16(sv[2], sv[3]); *(v2u*)(xcb + (size_t)(row0 + j) * DR + c4) = w; } }
    LAS float* scr = (LAS float*)(F.lds + F.wave * 16384);
    const int gw = F.vcu * NWAVES + F.wave, NGW = F.G * NWAVES;
    colmax_matrix(a.in[I_WG2], D, FF, a.in[I_N2], (unsigned*)(a.ws + WS_CTL) + CW_CM + 2 * FF, gw, NGW, lane_);
    colmax_matrix(a.in[I_WU2], D, FF, a.in[I_N2], (unsigned*)(a.ws + WS_CTL) + CW_CM + 3 * FF, gw, NGW, lane_);
    colmax_matrix(a.in[I_WD2], FF, D, nullptr, (unsigned*)(a.ws + WS_CTL) + CW_CMD, gw, NGW, lane_);
}

__device__ __forceinline__ void p6_scans(const Args& a, const Ctx& F) {
    PHASE_IDS
    unsigned* LA = (unsigned*)(a.out + DO_UA / 4); unsigned* BX = (unsigned*)(a.ws + WS_AX);
    float* segP = (float*)(a.ws + WS_SEG); float* segH = segP + 4 * NSEG * DR;
    for (int w = F.vcu; w < 256; w += F.G) { const int b = w >> 6, seg = (w >> 1) & 31, cp = (w & 1) * 512 + tid_;
        const size_t base = ((size_t)b * 4096 + seg * SEGL) * (DR / 2) + cp;
        float h0 = 0.f, h1 = 0.f, P0 = 1.f, P1 = 1.f;
        for (int t0 = 0; t0 < SEGL; t0 += 16) { unsigned lv[16], xv[16];
#pragma unroll
            for (int j = 0; j < 16; ++j) { lv[j] = LA[base + (size_t)(t0 + j) * (DR / 2)]; xv[j] = BX[base + (size_t)(t0 + j) * (DR / 2)]; }
#pragma unroll
            for (int j = 0; j < 16; ++j) { const float a0 = __builtin_amdgcn_exp2f(1.4426950408889634f * bf_lo(lv[j])), a1 = __builtin_amdgcn_exp2f(1.4426950408889634f * bf_hi(lv[j]));
                h0 = a0 * h0 + bf_lo(xv[j]); h1 = a1 * h1 + bf_hi(xv[j]); P0 *= a0; P1 *= a1;
                BX[base + (size_t)(t0 + j) * (DR / 2)] = cvt_pk_bf16(h0, h1); LA[base + (size_t)(t0 + j) * (DR / 2)] = cvt_pk_bf16(P0, P1); } }
        *(f32x2*)(segP + (size_t)(b * NSEG + seg) * DR + 2 * cp) = (f32x2){P0, P1}; *(f32x2*)(segH + (size_t)(b * NSEG + seg) * DR + 2 * cp) = (f32x2){h0, h1}; }
}

__device__ __forceinline__ void s5_carry_unit(const Args& a, int b, int g, int n) {
    bf16* U = (bf16*)(a.ws + WS_U); const float* E = a.out + DO_E / 4; const float* BBg = (const float*)(a.ws + WS_S5BB); const float* LAMg = (const float*)(a.ws + WS_S5LAM);
    const f32x4 lm = *(const f32x4*)(LAMg + (size_t)(g * 64 + n) * 4);
    f32x4 bq[8];
#pragma unroll
    for (int j = 0; j < 8; ++j) bq[j] = *(const f32x4*)(BBg + (size_t)(g * 64 + n) * 32 + 4 * j);
    float sr = 0.f, si = 0.f;
    const bf16* um = U + ((size_t)g * NCHP + NCHX) * UK;
    for (int s0 = 0; s0 < 16; s0 += 4) { v4u w0[4], w1[4];
#pragma unroll
        for (int q = 0; q < 4; ++q) { w0[q] = *(const v4u*)(um + (s0 + q) * 16); w1[q] = *(const v4u*)(um + (s0 + q) * 16 + 8); }
#pragma unroll
        for (int q = 0; q < 4; ++q) {
            const float uu[16] = {bf_lo(w0[q].x), bf_hi(w0[q].x), bf_lo(w0[q].y), bf_hi(w0[q].y), bf_lo(w0[q].z), bf_hi(w0[q].z), bf_lo(w0[q].w), bf_hi(w0[q].w),
                                  bf_lo(w1[q].x), bf_hi(w1[q].x), bf_lo(w1[q].y), bf_hi(w1[q].y), bf_lo(w1[q].z), bf_hi(w1[q].z), bf_lo(w1[q].w), bf_hi(w1[q].w)};
            float br = 0.f, bi = 0.f;
#pragma unroll
            for (int j = 0; j < 8; ++j) { br += bq[j][0] * uu[2 * j] + bq[j][2] * uu[2 * j + 1]; bi += bq[j][1] * uu[2 * j] + bq[j][3] * uu[2 * j + 1]; }
            const float nr = lm[0] * sr - lm[1] * si + br, ni = lm[0] * si + lm[1] * sr + bi; sr = nr; si = ni; } }
    bf16* up = U + ((size_t)g * NCHP + b * 256) * UK + 256 + 2 * n; const float* ep = E + ((size_t)g * NCHX + b * 256) * 128 + 2 * n;
    for (int k0 = 0; k0 < 256; k0 += 16) { f32x2 ev[16];
#pragma unroll
        for (int j = 0; j < 16; ++j) ev[j] = *(const f32x2*)(ep + (size_t)(k0 + j) * 128);
#pragma unroll
        for (int j = 0; j < 16; ++j) { *(unsigned*)(up + (size_t)(k0 + j) * UK) = cvt_pk_bf16(sr, si);
            const float nr = lm[2] * sr - lm[3] * si + ev[j].x, ni = lm[2] * si + lm[3] * sr + ev[j].y; sr = nr; si = ni; } }
}

__device__ __forceinline__ void p7_rgfix(const Args& a, const Ctx& F) {
    PHASE_IDS
    const bf16* PA = (const bf16*)(a.out + DO_UA / 4); const bf16* HL = (const bf16*)(a.ws + WS_AX); const bf16* GG = (const bf16*)(a.ws + WS_GG);
    const float* segP = (const float*)(a.ws + WS_SEG); const float* segH = segP + 4 * NSEG * DR; const float* gn = a.in[I_NRG];
    bf16* AO = (bf16*)(a.ws + WS_AX2);
    LAS f32x4* carry = (LAS f32x4*)(F.lds);
    for (int w = F.vcu; w < 256; w += F.G) { const int b = w >> 6, seg = (w >> 1) & 31, q = w & 1;
        { const int c4 = tid_ * 4; f32x4 h = {0.f, 0.f, 0.f, 0.f};
            for (int r0 = 0; r0 < 16; r0 += 8) { v2u pa[8], pb[8];
#pragma unroll
                for (int j = 0; j < 8; ++j) { pa[j] = *(const v2u*)(PA + (size_t)(MX + r0 + j) * DR + c4); pb[j] = *(const v2u*)(HL + (size_t)(MX + r0 + j) * DR + c4); }
#pragma unroll
                for (int j = 0; j < 8; ++j) { const f32x4 la = {bf_lo(pa[j].x), bf_hi(pa[j].x), bf_lo(pa[j].y), bf_hi(pa[j].y)}, bx = {bf_lo(pb[j].x), bf_hi(pb[j].x), bf_lo(pb[j].y), bf_hi(pb[j].y)};
                    f32x4 av;
#pragma unroll
                    for (int e = 0; e < 4; ++e) av[e] = __builtin_amdgcn_exp2f(1.4426950408889634f * la[e]);
                    h = av * h + bx; } }
            for (int s0 = 0; s0 < seg; s0 += 8) { f32x4 pa[8], pb[8];
#pragma unroll
                for (int j = 0; j < 8; ++j) { const bool ok = s0 + j < seg; const size_t o = (size_t)(b * NSEG + (ok ? s0 + j : 0)) * DR + c4;
                    pa[j] = *(const f32x4*)(segP + o); pb[j] = *(const f32x4*)(segH + o); if (!ok) { pa[j] = (f32x4){1.f, 1.f, 1.f, 1.f}; pb[j] = (f32x4){0.f, 0.f, 0.f, 0.f}; } }
#pragma unroll
                for (int j = 0; j < 8; ++j) h = pa[j] * h + pb[j]; }
            carry[tid_] = h; }
        __syncthreads();
        for (int rr = 0; rr < 8; ++rr) { const int row = b * 4096 + seg * SEGL + q * 64 + F.wave * 8 + rr;
            float y[4][8]; float s = 0.f;
#pragma unroll
            for (int j = 0; j < 4; ++j) { const int c = 8 * lane_ + 512 * j; const size_t off = (size_t)row * DR + c;
                const v4u hw = *(const v4u*)(HL + off), pw = *(const v4u*)(PA + off), gw = *(const v4u*)(GG + off); const f32x4 c0 = carry[2 * lane_ + 128 * j], c1 = carry[2 * lane_ + 128 * j + 1];
                const float hh[8] = {bf_lo(hw.x), bf_hi(hw.x), bf_lo(hw.y), bf_hi(hw.y), bf_lo(hw.z), bf_hi(hw.z), bf_lo(hw.w), bf_hi(hw.w)};
                const float pp[8] = {bf_lo(pw.x), bf_hi(pw.x), bf_lo(pw.y), bf_hi(pw.y), bf_lo(pw.z), bf_hi(pw.z), bf_lo(pw.w), bf_hi(pw.w)};
                const float gv[8] = {bf_lo(gw.x), bf_hi(gw.x), bf_lo(gw.y), bf_hi(gw.y), bf_lo(gw.z), bf_hi(gw.z), bf_lo(gw.w), bf_hi(gw.w)};
                const float cr[8] = {c0[0], c0[1], c0[2], c0[3], c1[0], c1[1], c1[2], c1[3]};
#pragma unroll
                for (int e = 0; e < 8; ++e) { y[j][e] = (hh[e] + pp[e] * cr[e]) * gv[e]; s += y[j][e] * y[j][e]; } }
            const float rs = __builtin_amdgcn_rsqf(wave_sum(s) * (1.0f / DR) + EPS);
#pragma unroll
            for (int j = 0; j < 4; ++j) { const int c = 8 * lane_ + 512 * j; const f32x4 g0 = *(const f32x4*)(gn + c), g1 = *(const f32x4*)(gn + c + 4);
                v4u wv; wv.x = cvt_pk_bf16(y[j][0] * rs * g0[0], y[j][1] * rs * g0[1]); wv.y = cvt_pk_bf16(y[j][2] * rs * g0[2], y[j][3] * rs * g0[3]);
                wv.z = cvt_pk_bf16(y[j][4] * rs * g1[0], y[j][5] * rs * g1[1]); wv.w = cvt_pk_bf16(y[j][6] * rs * g1[2], y[j][7] * rs * g1[3]);
                *(v4u*)(AO + (size_t)row * D + DR + c) = wv; } }
        __syncthreads(); }
}

__device__ __forceinline__ void p13_final(const Args& a, const Ctx& F) {
    PHASE_IDS
    const u64* ss = (const u64*)((const unsigned*)(a.ws + WS_CTL) + CW_SS) + 2 * MP; const bf16* T = (const bf16*)(a.ws + WS_H);
    const int gw = F.vcu * NWAVES + F.wave, NGW = F.G * NWAVES;
    for (int m = gw; m < MX; m += NGW) { const float rs = __builtin_amdgcn_rsqf(ss_get(ss + m) * (1.0f / D) + EPS);
        v4u w[8];
#pragma unroll
        for (int j = 0; j < 8; ++j) w[j] = *(const v4u*)(T + (size_t)m * D + 8 * lane_ + 512 * j);
#pragma unroll
        for (int j = 0; j < 8; ++j) { float* p = a.out + (size_t)m * D + 8 * lane_ + 512 * j;
            *(f32x4*)p = (f32x4){bf_lo(w[j].x) * rs, bf_hi(w[j].x) * rs, bf_lo(w[j].y) * rs, bf_hi(w[j].y) * rs}; *(f32x4*)(p + 4) = (f32x4){bf_lo(w[j].z) * rs, bf_hi(w[j].z) * rs, bf_lo(w[j].w) * rs, bf_hi(w[j].w) * rs}; } }
}

__device__ __forceinline__ f32x4 skinny_tile(const bf16* A, int lda, const bf16* Bt, int ldb, int ksteps, int wave, int lane, LAS float* red) {
    typedef short bf16x8 __attribute__((ext_vector_type(8)));
    const int fr = lane & 15, fq = lane >> 4;
    const bf16* ap = A + (size_t)fr * lda + (size_t)wave * ksteps * 32 + 8 * fq;
    const bf16* bp = Bt + (size_t)fr * ldb + (size_t)wave * ksteps * 32 + 8 * fq;
    f32x4 acc = {0.f, 0.f, 0.f, 0.f};
    int s0 = 0;
    for (; s0 + 8 <= ksteps; s0 += 8) { bf16x8 av[8], bv[8];
#pragma unroll
        for (int j = 0; j < 8; ++j) { av[j] = *(const bf16x8*)(ap + 32 * (s0 + j)); bv[j] = *(const bf16x8*)(bp + 32 * (s0 + j)); }
#pragma unroll
        for (int j = 0; j < 8; ++j) acc = __builtin_amdgcn_mfma_f32_16x16x32_bf16(bv[j], av[j], acc, 0, 0, 0); }
    for (; s0 < ksteps; ++s0) { const bf16x8 av = *(const bf16x8*)(ap + 32 * s0), bv = *(const bf16x8*)(bp + 32 * s0); acc = __builtin_amdgcn_mfma_f32_16x16x32_bf16(bv, av, acc, 0, 0, 0); }
    *(LAS f32x4*)(red + (wave * 64 + lane) * 4) = acc;
    __syncthreads();
    f32x4 r = {0.f, 0.f, 0.f, 0.f};
    if (wave == 0) {
#pragma unroll
        for (int w = 0; w < 8; ++w) r += *(const LAS f32x4*)(red + (w * 64 + lane) * 4); }
    __syncthreads();
    return r;
}
__device__ __forceinline__ void skinny_g2_meta(const Args& a, const Ctx& F) {
    PHASE_IDS
    const bf16* Hm = (const bf16*)(a.ws + WS_H) + (size_t)MX * FF; const bf16* Wd = (const bf16*)(a.ws + WS_W1D);
    const float* h0 = (const float*)(a.ws + WS_H0M); bf16* HB = (bf16*)(a.ws + WS_HB); u64* ss = (u64*)((unsigned*)(a.ws + WS_CTL) + CW_SS);
    for (int nb = F.vcu; nb < D / 16; nb += F.G) { const int n0 = nb * 16;
        const f32x4 c = skinny_tile(Hm, FF, Wd + (size_t)n0 * FF, FF, FF / 32 / 8, F.wave, lane_, (LAS float*)F.lds);
        if (F.wave == 0) { const int fr = lane_ & 15, col = n0 + 4 * (lane_ >> 4);
            const f32x4 v = *(const f32x4*)(h0 + (size_t)fr * D + col) + c;
            v2u o; o.x = cvt_pk_bf16(v[0], v[1]); o.y = cvt_pk_bf16(v[2], v[3]); *(v2u*)(HB + (size_t)(MX + fr) * D + col) = o;
            float q = (v[0] * v[0] + v[1] * v[1]) + (v[2] * v[2] + v[3] * v[3]); q += __shfl_xor(q, 16); q += __shfl_xor(q, 32);
            if (lane_ < 16) ss_add(ss + MX + fr, q); } }
}
__device__ __forceinline__ void skinny_win_meta(const Args& a, const Ctx& F) {
    PHASE_IDS
    const bf16* Am = (const bf16*)(a.ws + WS_HB) + (size_t)MX * D; const bf16* Wi = (const bf16*)(a.ws + WS_WIN);
    const u64* ss = (const u64*)((const unsigned*)(a.ws + WS_CTL) + CW_SS); bf16* urg = (bf16*)((char*)a.out + DO_URG); bf16* U = (bf16*)(a.ws + WS_U);
    for (int nb = F.vcu; nb < 256; nb += F.G) { const int n0 = (nb < 128) ? nb * 16 : 4096 + (nb - 128) * 16;
        const f32x4 c = skinny_tile(Am, D, Wi + (size_t)n0 * D, D, D / 32 / 8, F.wave, lane_, (LAS float*)F.lds);
        if (F.wave == 0) { const int fr = lane_ & 15, c4 = 4 * (lane_ >> 4);
            const f32x4 v = c * __builtin_amdgcn_rsqf(ss_get(ss + MX + fr) * (1.0f / D) + EPS);
            v2u o; o.x = cvt_pk_bf16(v[0], v[1]); o.y = cvt_pk_bf16(v[2], v[3]);
            if (nb < 128) *(v2u*)(urg + (size_t)(MX + fr) * DR + n0 + c4) = o;
            else *(v2u*)(U + ((size_t)(nb - 128) * NCHP + NCHX) * UK + fr * 16 + c4) = o; } }
}


__device__ __forceinline__ void skinny_gates_meta(const Args& a, const Ctx& F) {
    PHASE_IDS
    const bf16* xcb = (const bf16*)(a.ws + WS_XCB) + (size_t)MX * DR; const bf16* Wrg = (const bf16*)(a.ws + WS_WRG); const float* c8t = (const float*)(a.ws + WS_C8);
    bf16* LA = (bf16*)(a.out + DO_UA / 4); bf16* BX = (bf16*)(a.ws + WS_AX);
    for (int nb = F.vcu; nb < DR / 16; nb += F.G) { const int ch0 = nb * 16, h = ch0 >> 8, hf = (ch0 >> 7) & 1, j0 = ch0 & 127;
        const bf16* Wa = Wrg + (size_t)((h * 2 + hf) * 256 + j0) * 256;
        const f32x4 ta = skinny_tile(xcb + h * 256, DR, Wa, 256, 1, F.wave, lane_, (LAS float*)F.lds);
        const f32x4 tx = skinny_tile(xcb + h * 256, DR, Wa + 128 * 256, 256, 1, F.wave, lane_, (LAS float*)F.lds);
        if (F.wave == 0) { const int fr = lane_ & 15, c = ch0 + 4 * (lane_ >> 4);
            const f32x4 ba = *(const f32x4*)(a.in[I_BA] + c), bx = *(const f32x4*)(a.in[I_BX] + c), c8 = *(const f32x4*)(c8t + c);
            const v2u xw = *(const v2u*)(xcb + (size_t)fr * DR + c); const f32x4 xv = {bf_lo(xw.x), bf_hi(xw.x), bf_lo(xw.y), bf_hi(xw.y)};
            f32x4 l;
#pragma unroll
            for (int e = 0; e < 4; ++e) l[e] = c8[e] * fsigmoid(ta[e] + ba[e]);
            v2u lw; lw.x = cvt_pk_bf16(l[0], l[1]); lw.y = cvt_pk_bf16(l[2], l[3]);
            const f32x4 r = {bf_lo(lw.x), bf_hi(lw.x), bf_lo(lw.y), bf_hi(lw.y)}; f32x4 o;
#pragma unroll
            for (int e = 0; e < 4; ++e) o[e] = __builtin_amdgcn_sqrtf(one_minus_exp(2.0f * r[e])) * fsigmoid(tx[e] + bx[e]) * xv[e];
            v2u ow; ow.x = cvt_pk_bf16(o[0], o[1]); ow.y = cvt_pk_bf16(o[2], o[3]);
            *(v2u*)(LA + (size_t)(MX + fr) * DR + c) = lw; *(v2u*)(BX + (size_t)(MX + fr) * DR + c) = ow; } }
}

__global__ void __launch_bounds__(NTHR, 2) hymba_fwd(Args a) {
    extern __shared__ __attribute__((aligned(16))) unsigned char lds_raw[];
    Ctx F; F.lds = (LAS unsigned char*)lds_raw; F.wave = __builtin_amdgcn_readfirstlane((int)threadIdx.x >> 6);
    F.G = gridDim.x; { const int bx = blockIdx.x; F.vcu = (F.G % 8 == 0) ? (bx % 8) * (F.G / 8) + bx / 8 : bx; }
    volatile LAS unsigned* MISC = (volatile LAS unsigned*)(F.lds + MISC_OFF);
    for (int u = threadIdx.x; u < (LDS_BYTES - RING_BYTES) / 4; u += NTHR) ((LAS unsigned*)(F.lds + RING_BYTES))[u] = 0u;
    __syncthreads();
    unsigned* ctl = (unsigned*)(a.ws + WS_CTL);
    XcdBarrier bar; bar.bar = ctl + CW_BAR; bar.x = 0; bar.st = nullptr;
    if (MK_N_LAUNCHES == 1) bar = xcd_barrier_post(ctl + CW_BAR, MISC + 8);
    const int lo = a.ph_lo, hi = a.ph_hi;
#define IN(k) (lo <= (k) && (k) < hi)
#define SEAM(k) do { if (IN(k) && IN((k) + 1)) xcd_barrier(bar); if (PROBE_SPIN >= 0 && blockIdx.x == 0 && threadIdx.x == 0) { ((unsigned long long*)(ctl + 3000))[(k) + 1] = wall_clock64(); ((unsigned long long*)(ctl + 3000))[100 + (k) + 1] = clock64(); } } while (0)
    u64* ssb = (u64*)(ctl + CW_SS);
    bf16* AX = (bf16*)(a.ws + WS_AX); bf16* HH = (bf16*)(a.ws + WS_H); bf16* HB = (bf16*)(a.ws + WS_HB);
    const int me = (int)blockIdx.x;

    if (PROBE_SPIN >= 0 && blockIdx.x == 0 && threadIdx.x == 0) ((unsigned long long*)(ctl + 3000))[0] = wall_clock64();
    if (IN(0)) { p0_prologue(a, F); } SEAM(0);
    if (IN(1)) { p1_quant_w1(a, F); } SEAM(1);
    if (IN(2)) {
        pg8::Gemm g{(const bf16*)(a.ws + WS_AX), (const bf16*)(a.ws + WS_W1GU), D / 2, D / 2, D / 2, 0, 0u}; pg8::StaticOrder S; S.init(NPP, 2 * FF / 256, F.G, me, 16, 16);
        EpiSwigluI8<false> E{HH, (const float*)(a.ws + WS_SW + 131072), nullptr, (const float*)(a.ws + WS_SW), nullptr};
        pg8::gemm_phase<EpiSwigluI8<false>, true, true, false, (PROBE_SPIN >= 30 && PROBE_GP == 2), true>(F.lds, F.wave, g, S, E, nullptr, 0.f, 0.f, (unsigned long long*)(ctl + 3000) + 30); } SEAM(2);
    if (IN(3)) {
        skinny_g2_meta(a, F);
        pg8::Gemm g{HH, (const bf16*)(a.ws + WS_W1D), FF, FF, FF, 0, 0u}; pg8::StaticOrder S; S.init(NPX, D / 256, F.G, me, 16, 16);
        EpiResidB<true, false> E{a.in[I_X], HB, nullptr, ssb};
        pg8::gemm_phase<EpiResidB<true, false>, true, true>(F.lds, F.wave, g, S, E); } SEAM(3);
    if (IN(4)) {
        skinny_win_meta(a, F);
        pg8::Gemm g{HB, (const bf16*)(a.ws + WS_WIN), D, D, D, 0, 0u}; pg8::StaticOrder S; S.init(NPX, 6144 / 256, F.G, me, 32, 8);
        EpiWin E{ssb, (bf16*)((char*)a.out + DO_URG), (bf16*)(a.ws + WS_GG), (bf16*)(a.ws + WS_U)};
        pg8::gemm_phase<EpiWin, true, true>(F.lds, F.wave, g, S, E); } SEAM(4);
    if (IN(5)) { p4_conv(a, F); } SEAM(5);
    if (IN(6)) {
        skinny_gates_meta(a, F);
        { pg8::Gemm g{(const bf16*)(a.ws + WS_XCB), (const bf16*)(a.ws + WS_WRG), DR, 256, 256, 1, 512u}; pg8::StaticOrder S; S.init(NPX, 16, F.G, me);
          EpiGates E{a.in[I_BA], a.in[I_BX], (const float*)(a.ws + WS_C8), (const bf16*)(a.ws + WS_XCB), (bf16*)(a.out + DO_UA / 4), (bf16*)(a.ws + WS_AX)};
          pg8::gemm_phase<EpiGates, true, true>(F.lds, F.wave, g, S, E); }
        { pg8::StaticOrder S; S.init(4, NG, F.G, me);
          { pg8::Gemm g{(const bf16*)(a.ws + WS_U), (const bf16*)(a.ws + WS_S5P), UK, 256, 256, 0, (unsigned)(NCHP * UK * 2)};
            EpiS5E E{a.out + DO_E / 4};
            pg8::gemm_phase<EpiS5E, true, true>(F.lds, F.wave, g, S, E); }
          { __builtin_amdgcn_fence(__ATOMIC_ACQUIRE, "agent");
            for (int i = F.wave; ; i += NWAVES) { pg8::Unit u; if (!S.next(i, u)) break; s5_carry_unit(a, u.pm, u.pn, pg8::lane_id_opaque()); }
            VM_WAIT(); __syncthreads(); __builtin_amdgcn_fence(__ATOMIC_ACQUIRE, "agent"); VM_WAIT(); __syncthreads(); }
          { pg8::Gemm g{(const bf16*)(a.ws + WS_U), (const bf16*)(a.ws + WS_S5TQ), UK, UK, UK, 0, (unsigned)(NCHP * UK * 2)};
            EpiS5Y E{(bf16*)(a.ws + WS_Z)};
            pg8::gemm_phase<EpiS5Y, true, true>(F.lds, F.wave, g, S, E); } } } SEAM(6);
    if (IN(7)) {
        p6_scans(a, F);
        pg8::Gemm g{(const bf16*)(a.ws + WS_Z), (const bf16*)(a.ws + WS_WGLU), DS, DS, DS, 0, 0u}; pg8::StaticOrder S; S.init(NPX, DS / 256, F.G, me, 32, 8);
        EpiGlu E{(const bf16*)(a.ws + WS_Z), a.in[I_GLUB], a.in[I_NS5], (bf16*)(a.ws + WS_AX2), ssb + 3 * MP};
        pg8::gemm_phase<EpiGlu, true, true>(F.lds, F.wave, g, S, E); } SEAM(7);
    if (IN(8)) { p7_rgfix(a, F); p8_quant_w2(a, F); } SEAM(8);
    if (IN(9)) {
        pg8::Gemm g{(const bf16*)(a.ws + WS_AX2), (const bf16*)(a.ws + WS_WOUT), D, D, D, 0, 0u}; pg8::StaticOrder S; S.init(NPX, D / 256, F.G, me, 16, 16);
        EpiResidB<false, false> E{HB, HB, nullptr, ssb + MP};
        pg8::gemm_phase<EpiResidB<false, false>, true, true, true, (PROBE_SPIN >= 30 && PROBE_GP == 9)>(F.lds, F.wave, g, S, E, ssb + 3 * MP, 1.0f / DS, EPS, (unsigned long long*)(ctl + 3000) + 30); } SEAM(9);
    if (IN(10)) { p10_quant_h2(a, F); } SEAM(10);
    if (IN(11)) {
        pg8::Gemm g{(const bf16*)(a.ws + WS_AX), (const bf16*)(a.ws + WS_W1GU), D / 2, D / 2, D / 2, 0, 0u}; pg8::StaticOrder S; S.init(NPX, 2 * FF / 256, F.G, me, 16, 16);
        EpiSwigluI8<false> E{HH, (const float*)(a.ws + WS_SW + 131072), nullptr, (const float*)(a.ws + WS_SW), nullptr};
        pg8::gemm_phase<EpiSwigluI8<false>, true, true, false, (PROBE_SPIN >= 30 && PROBE_GP == 11), true>(F.lds, F.wave, g, S, E, nullptr, 0.f, 0.f, (unsigned long long*)(ctl + 3000) + 30); } SEAM(11);
    if (IN(12)) { p12_quant_h(a, F); } SEAM(12);
    if (IN(13)) {
        pg8::Gemm g{(const bf16*)(a.ws + WS_AX), (const bf16*)(a.ws + WS_W1D), FF / 2, FF / 2, FF / 2, 0, 0u}; pg8::StaticOrder S; S.init(NPX, D / 256, F.G, me, 16, 16);
        EpiResidI8 E{HB, HH, a.in[I_NFIN], ssb + 2 * MP, (const float*)(a.ws + WS_SW + 393216), (const float*)(a.ws + WS_SW + 262144)};
        pg8::gemm_phase<EpiResidI8, true, true, false, false, true>(F.lds, F.wave, g, S, E); } SEAM(13);
    if (IN(14)) { p13_final(a, F); }
    if (PROBE_SPIN >= 0 && blockIdx.x == PROBE_BLK && threadIdx.x == 0) { VM_WAIT(); const unsigned long long t1 = wall_clock64(); const unsigned long long* ts = (const unsigned long long*)(ctl + 3000);
        unsigned long long dt = (PROBE_SPIN >= 30) ? (ts[PROBE_B] - ts[PROBE_A]) : (((PROBE_SPIN == N_PHASES - 1) ? t1 : ts[PROBE_SPIN + 1]) - ts[PROBE_SPIN]);
        if (PROBE_SPIN >= 100) { const int p = PROBE_SPIN - 100; dt = (ts[100 + p + 1] - ts[100 + p]) * 10000ull / (ts[p + 1] - ts[p]); }
        const unsigned long long until = t1 + (unsigned long long)(PROBE_SPIN >= 100 ? 1 : (PROBE_SPIN >= 30 ? PROBE_MUL : 10)) * dt;
        while (wall_clock64() < until) __builtin_amdgcn_s_sleep(16); }
#undef IN
#undef SEAM
}

extern "C" void kernel_launch(void* const* d_in, const int* in_sizes, int n_in, void* d_out, int out_size, void* d_ws, size_t ws_size, hipStream_t stream) {
    static int grid = 0;
    if (grid == 0) {
        if (n_in != 33 || in_sizes[0] != MX * D || out_size != MX * D || ws_size < WS_END) { fprintf(stderr, "kernel_launch: shape/workspace mismatch (n_in %d, ws %zu < %zu)\n", n_in, ws_size, (size_t)WS_END); grid = -1; return; }
        int dev = 0, cus = 0, per_cu = 0;
        if (hipGetDevice(&dev) != hipSuccess || hipDeviceGetAttribute(&cus, hipDeviceAttributeMultiprocessorCount, dev) != hipSuccess) { grid = -1; return; }
        if (hipFuncSetAttribute((const void*)hymba_fwd, hipFuncAttributeMaxDynamicSharedMemorySize, LDS_BYTES) != hipSuccess) { fprintf(stderr, "kernel_launch: hipFuncSetAttribute failed\n"); grid = -1; return; }
        if (hipOccupancyMaxActiveBlocksPerMultiprocessor(&per_cu, (const void*)hymba_fwd, NTHR, LDS_BYTES) != hipSuccess || per_cu < 1) fprintf(stderr, "kernel_launch: occupancy query says %d\n", per_cu);
        (void)hipGetLastError();
        grid = cus;
    }
    if (grid < 0) return;
    if (hipMemsetAsync((char*)d_ws + WS_CTL, 0, CTL_ZERO_BYTES, stream) != hipSuccess) return;
    Args a{};
    for (int i = 0; i < 33; ++i) a.in[i] = (const float*)d_in[i];
    a.out = (float*)d_out; a.ws = (unsigned char*)d_ws;
    if (MK_N_LAUNCHES == 1) { a.ph_lo = 0; a.ph_hi = N_PHASES; hipLaunchKernelGGL(hymba_fwd, dim3(grid), dim3(NTHR), LDS_BYTES, stream, a); }
    else for (int p = 0; p < N_PHASES; ++p) { a.ph_lo = p; a.ph_hi = p + 1; hipLaunchKernelGGL(hymba_fwd, dim3(grid), dim3(NTHR), LDS_BYTES, stream, a); }
    const hipError_t le = hipPeekAtLastError();
    if (le != hipSuccess) fprintf(stderr, "kernel_launch: launch failed: %s\n", hipGetErrorName(le));
}
```

```cpp
#include <hip/hip_runtime.h>
#include <cstdio>
#include <cstdint>

#ifndef PROBE_DUP
#define PROBE_DUP -1
#endif
#ifndef PROBE_SPIN
#define PROBE_SPIN -1
#endif
#ifndef PROBE_A
#define PROBE_A 30
#define PROBE_B 31
#define PROBE_MUL 1
#define PROBE_BLK 0
#endif
#ifndef PROBE_GP
#define PROBE_GP 2
#endif
#ifndef MK_N_LAUNCHES
#define MK_N_LAUNCHES 1
#endif

namespace pg8 {
#define PG8_LAS __attribute__((address_space(3)))
typedef unsigned short bf16_t;
typedef short bf16x8 __attribute__((ext_vector_type(8)));
typedef float f32x4 __attribute__((ext_vector_type(4)));
typedef unsigned u32x4 __attribute__((ext_vector_type(4)));
typedef int i32x4 __attribute__((ext_vector_type(4)));
template <bool I8> struct AccT { typedef f32x4 type; }; template <> struct AccT<true> { typedef i32x4 type; };
__device__ __forceinline__ f32x4 mma16(bf16x8 b, bf16x8 a, f32x4 c) { return __builtin_amdgcn_mfma_f32_16x16x32_bf16(b, a, c, 0, 0, 0); }
__device__ __forceinline__ i32x4 mma16(bf16x8 b, bf16x8 a, i32x4 c) { return __builtin_amdgcn_mfma_i32_16x16x64_i8(__builtin_bit_cast(i32x4, b), __builtin_bit_cast(i32x4, a), c, 0, 0, 0); }
constexpr int BM = 256, BK = 64, HALF = 128, HTB = HALF * BK * 2, STAGE_BYTES = 8 * HTB, NXCD = 8, WGM = 8;

__host__ __device__ __forceinline__ int lds_byte(int r, int c) { const int st = (r >> 4) * 2 + (c >> 5), rr = r & 15, cc = c & 31, ob = rr * 64 + cc * 2; return st * 1024 + (ob ^ (((ob >> 9) & 1) << 5)); }
__host__ __device__ __forceinline__ void stage_rc(int b, int& R, int& C) { const int st = b / 1024, sb = b % 1024, swz = sb ^ (((sb >> 9) & 1) << 5); R = (st >> 1) * 16 + swz / 64; C = (st & 1) * 32 + (swz % 64) / 2; }
__host__ __device__ __forceinline__ int perm32(int rho) { const int n = rho >> 4, i = rho & 15; return 8 * (i >> 2) + 4 * n + (i & 3); }

__device__ __forceinline__ int lane_id_opaque() { int l; asm volatile("v_mbcnt_lo_u32_b32 %0, -1, 0\n\tv_mbcnt_hi_u32_b32 %0, -1, %0" : "=v"(l)); return l; }
struct Unit { int pm, pn; };
struct Gemm { const bf16_t* A; const bf16_t* Bt; int lda, ldb, K, a_shift; unsigned a_stride; };

struct StaticOrder {
    int nM, nN, nwg, G, c, chunked, wb;
    __device__ __forceinline__ void init(int nM_, int nN_, int G_, int c_, int chunked_ = 0, int wb_ = 16) { nM = nM_; nN = nN_; nwg = nM * nN; G = G_; c = c_; chunked = chunked_; wb = wb_; }
    __device__ __forceinline__ bool next(int i, Unit& u) const {
        const long L = (long)i * G + c; if (L >= nwg) return false;
        if (chunked) { const int CP = chunked, per_chunk = CP * nN, nch = nM / CP;
            int ch = (int)L / per_chunk, w = (int)L % per_chunk;
            if (ch >= nch) { const int e = (int)L - nch * per_chunk; u.pm = nch * CP + e / nN; u.pn = e % nN; return true; }
            const int full = (nN / wb) * CP * wb; int jb, r, wbj;
            if (w < full) { jb = w / (CP * wb); r = w % (CP * wb); wbj = wb; } else { jb = nN / wb; r = w - full; wbj = nN % wb; }
            const int gy = 32 / CP, xcd = r & 7, loc = r >> 3, pq = wbj / gy;
            u.pm = ch * CP + (xcd / gy) * 4 + (loc & 3); u.pn = jb * wb + (xcd % gy) * pq + (loc >> 2); return true; }
        int wgid = (int)L; { const int q = nwg / NXCD, r = nwg % NXCD, xcd = wgid % NXCD, off = wgid / NXCD; wgid = (xcd < r ? xcd * (q + 1) : r * (q + 1) + (xcd - r) * q) + off; }
        const int nig = WGM * nN, gid = wgid / nig, fm = gid * WGM, gsz = (nM - fm) < WGM ? (nM - fm) : WGM;
        u.pm = fm + ((wgid % nig) % gsz); u.pn = (wgid % nig) / gsz; return true;
    }
};

__device__ __forceinline__ unsigned cvt_pk_bf16(float lo, float hi) { unsigned r; asm volatile("v_cvt_pk_bf16_f32 %0, %1, %2" : "=v"(r) : "v"(lo), "v"(hi)); return r; }

template <class Epi, bool ALIGN_EPI, bool SP2, bool HOOK = false, bool STAMPS = false, bool I8 = false>
__device__ __forceinline__ void gemm_phase(PG8_LAS unsigned char* lds, const int wid, const Gemm g, const StaticOrder& S, const Epi& E, const unsigned long long* hss = nullptr, float hinv = 0.f, float heps = 0.f, unsigned long long* st = nullptr) {
    const int lane = lane_id_opaque(), tid = wid * 64 + lane, wr = wid >> 2, wc = wid & 3, fr = lane & 15, fq = lane >> 4;
    const int K = g.K, nt = K / BK;
    unsigned voffA[2], voffB[2];
#pragma unroll
    for (int i = 0; i < 2; ++i) { int R, C; stage_rc(tid * 16 + i * 8192, R, C); const int Rb = (R & ~31) + perm32(R & 31);
        voffA[i] = (unsigned)(R * g.lda + C) * 2u; voffB[i] = (unsigned)(Rb * g.ldb + C) * 2u; }
    const size_t kstep = (size_t)(BK * 2);
    const size_t hA = (size_t)HALF * g.lda * 2, hB = (size_t)HALF * g.ldb * 2;
    const size_t tA = 2 * hA, tB = 2 * hB;
    const unsigned ldsw = (unsigned)wid * 1024u;
    const int aoff = lds_byte(wr * 64 + fr, fq * 8), boff = lds_byte(wc * 32 + fr, fq * 8);
#define PG8_SA(b, h) (((b) * 2 + (h)) * HTB)
#define PG8_SB(b, h) ((4 + (b) * 2 + (h)) * HTB)
#define PG8_STAGE(bufoff, gbase, voff) do { _Pragma("unroll") for (int _i = 0; _i < 2; ++_i) \
        __builtin_amdgcn_global_load_lds((const unsigned*)((const char*)(gbase) + (voff)[_i]), (PG8_LAS unsigned*)(lds + (bufoff) + ldsw + _i * 8192), 16, 0, 0); } while (0)
#define PG8_LDA(dst, b, h) do { _Pragma("unroll") for (int m = 0; m < 4; ++m) _Pragma("unroll") for (int k = 0; k < 2; ++k) dst[m][k] = *(const PG8_LAS bf16x8*)(lds + PG8_SA(b, h) + aoff + m * 2048 + k * 1024); } while (0)
#define PG8_LDB(dst, b, h) do { _Pragma("unroll") for (int n = 0; n < 2; ++n) _Pragma("unroll") for (int k = 0; k < 2; ++k) dst[n][k] = *(const PG8_LAS bf16x8*)(lds + PG8_SB(b, h) + boff + n * 2048 + k * 1024); } while (0)
#define PG8_MMA(ai, bj, At, Bt) do { __builtin_amdgcn_s_setprio(1); _Pragma("unroll") for (int m = 0; m < 4; ++m) _Pragma("unroll") for (int n = 0; n < 2; ++n) _Pragma("unroll") for (int k = 0; k < 2; ++k) \
        acc[ai][bj][m][n] = mma16(Bt[n][k], At[m][k], acc[ai][bj][m][n]); __builtin_amdgcn_s_setprio(0); } while (0)
#define PG8_WAIT_V(n) asm volatile("s_waitcnt vmcnt(" #n ")" ::: "memory")
#define PG8_WAIT_L(n) asm volatile("s_waitcnt lgkmcnt(" #n ")" ::: "memory")
#define PG8_BAR __builtin_amdgcn_s_barrier()
#define PG8_SCHED __builtin_amdgcn_sched_barrier(0)
#define PG8_ST(k) do { if constexpr (STAMPS) { if (wid == 0 && lane == 0 && blockIdx.x == PROBE_BLK) st[k] = wall_clock64(); } } while (0)
    Unit cur, nxt; int ui = 0;
    if (!S.next(0, cur)) return;
    PG8_ST(0);
    typedef typename AccT<I8>::type acc_t; static_assert(!(I8 && HOOK), "no float hook on integer accumulators");
    acc_t acc[2][2][4][2];
#pragma unroll
    for (int a = 0; a < 2; ++a)
#pragma unroll
        for (int b = 0; b < 2; ++b)
#pragma unroll
            for (int m = 0; m < 4; ++m)
#pragma unroll
                for (int n = 0; n < 2; ++n) acc[a][b][m][n] = (acc_t){0, 0, 0, 0};
    bf16x8 At[4][2], B0[2][2], B1[2][2];
    const char* cA = (const char*)g.A + (size_t)cur.pm * tA + (size_t)(cur.pn >> g.a_shift) * g.a_stride; const char* cB = (const char*)g.Bt + (size_t)cur.pn * tB;
    if constexpr (SP2) {
        PG8_STAGE(PG8_SB(0, 0), cB, voffB); PG8_STAGE(PG8_SB(0, 1), cB + hB, voffB); PG8_STAGE(PG8_SA(0, 0), cA, voffA); PG8_STAGE(PG8_SA(0, 1), cA + hA, voffA);
        if (wr == 1) PG8_BAR;
        PG8_WAIT_V(2); PG8_BAR;
        PG8_STAGE(PG8_SB(1, 0), cB + kstep, voffB); PG8_STAGE(PG8_SA(1, 0), cA + kstep, voffA); PG8_STAGE(PG8_SB(1, 1), cB + hB + kstep, voffB);
        PG8_WAIT_V(6); PG8_BAR;
    } else {
        PG8_STAGE(PG8_SB(0, 0), cB, voffB); PG8_STAGE(PG8_SA(0, 0), cA, voffA); PG8_STAGE(PG8_SB(0, 1), cB + hB, voffB); PG8_STAGE(PG8_SA(0, 1), cA + hA, voffA);
        if (wr == 1) PG8_BAR;
        PG8_WAIT_V(4); PG8_BAR;
        PG8_STAGE(PG8_SB(1, 0), cB + kstep, voffB); PG8_STAGE(PG8_SA(1, 0), cA + kstep, voffA); PG8_STAGE(PG8_SB(1, 1), cB + hB + kstep, voffB);
        PG8_WAIT_V(6); PG8_BAR;
    }
    PG8_ST(1);
    for (;;) {
        const bool has_next = S.next(ui + 1, nxt);
        const char* nA = has_next ? (const char*)g.A + (size_t)nxt.pm * tA + (size_t)(nxt.pn >> g.a_shift) * g.a_stride : cA; const char* nB = has_next ? (const char*)g.Bt + (size_t)nxt.pn * tB : cB;
#pragma nounroll
        for (int t = 0; t < nt; t += 2) {
            const bool last = (t == nt - 2);
            if constexpr (HOOK) { if (t == (nt >> 1)) {
                float hsc[2][4];
#pragma unroll
                for (int a_ = 0; a_ < 2; ++a_)
#pragma unroll
                    for (int m_ = 0; m_ < 4; ++m_) hsc[a_][m_] = __builtin_amdgcn_rsqf((float)hss[cur.pm * 256 + a_ * 128 + wr * 64 + m_ * 16 + fr] * 2.3283064365386963e-10f * hinv + heps);
#pragma unroll
                for (int a_ = 0; a_ < 2; ++a_)
#pragma unroll
                    for (int b_ = 0; b_ < 2; ++b_)
#pragma unroll
                        for (int m_ = 0; m_ < 4; ++m_)
#pragma unroll
                            for (int n_ = 0; n_ < 2; ++n_) acc[a_][b_][m_][n_] *= hsc[a_][m_]; } }
            const char* a1 = cA + (size_t)(t + 1) * kstep;
            const char* a2 = last ? nA : cA + (size_t)(t + 2) * kstep; const char* b2 = last ? nB : cB + (size_t)(t + 2) * kstep;
            const char* a3 = a2 + kstep; const char* b3 = b2 + kstep;
            if constexpr (SP2) {
            PG8_LDB(B0, 0, 0); PG8_LDB(B1, 0, 1); PG8_SCHED; PG8_LDA(At, 0, 0); PG8_STAGE(PG8_SA(1, 1), a1 + hA, voffA);
            PG8_WAIT_V(8); PG8_WAIT_L(0); PG8_BAR; PG8_MMA(0, 0, At, B0); PG8_MMA(0, 1, At, B1); PG8_BAR; PG8_SCHED;
            PG8_LDA(At, 0, 1); PG8_STAGE(PG8_SB(0, 0), b2, voffB); PG8_STAGE(PG8_SB(0, 1), b2 + hB, voffB); PG8_STAGE(PG8_SA(0, 0), a2, voffA);
            PG8_WAIT_V(8); PG8_WAIT_L(0); PG8_BAR; PG8_MMA(1, 0, At, B0); PG8_MMA(1, 1, At, B1); PG8_BAR; PG8_SCHED;
            PG8_LDB(B0, 1, 0); PG8_LDB(B1, 1, 1); PG8_SCHED; PG8_LDA(At, 1, 0); PG8_STAGE(PG8_SA(0, 1), a2 + hA, voffA);
            PG8_WAIT_V(8); PG8_WAIT_L(0); PG8_BAR; PG8_MMA(0, 0, At, B0); PG8_MMA(0, 1, At, B1); PG8_BAR; PG8_SCHED;
            PG8_LDA(At, 1, 1); PG8_STAGE(PG8_SB(1, 0), b3, voffB); PG8_STAGE(PG8_SB(1, 1), b3 + hB, voffB); PG8_STAGE(PG8_SA(1, 0), a3, voffA);
            PG8_WAIT_V(8); PG8_WAIT_L(0); PG8_BAR; PG8_MMA(1, 0, At, B0); PG8_MMA(1, 1, At, B1); PG8_BAR; PG8_SCHED;
            } else {
            PG8_LDB(B0, 0, 0); PG8_SCHED; PG8_LDA(At, 0, 0); PG8_STAGE(PG8_SA(1, 1), a1 + hA, voffA);
            PG8_WAIT_L(8); PG8_BAR; PG8_WAIT_L(0); PG8_MMA(0, 0, At, B0); PG8_BAR; PG8_SCHED;
            PG8_LDB(B1, 0, 1); PG8_STAGE(PG8_SB(0, 0), b2, voffB);
            PG8_BAR; PG8_WAIT_L(0); PG8_MMA(0, 1, At, B1); PG8_BAR;
            PG8_LDA(At, 0, 1); PG8_STAGE(PG8_SA(0, 0), a2, voffA);
            PG8_BAR; PG8_WAIT_L(0); PG8_MMA(1, 0, At, B0); PG8_BAR; PG8_SCHED;
            PG8_STAGE(PG8_SB(0, 1), b2 + hB, voffB);
            PG8_WAIT_V(6); PG8_BAR; PG8_MMA(1, 1, At, B1); PG8_BAR;
            PG8_LDB(B0, 1, 0); PG8_SCHED; PG8_LDA(At, 1, 0); PG8_STAGE(PG8_SA(0, 1), a2 + hA, voffA);
            PG8_WAIT_L(8); PG8_BAR; PG8_WAIT_L(0); PG8_MMA(0, 0, At, B0); PG8_BAR; PG8_SCHED;
            PG8_LDB(B1, 1, 1); PG8_STAGE(PG8_SB(1, 0), b3, voffB);
            PG8_BAR; PG8_WAIT_L(0); PG8_MMA(0, 1, At, B1); PG8_BAR;
            PG8_LDA(At, 1, 1); PG8_STAGE(PG8_SA(1, 0), a3, voffA);
            PG8_BAR; PG8_WAIT_L(0); PG8_MMA(1, 0, At, B0); PG8_BAR; PG8_SCHED;
            PG8_STAGE(PG8_SB(1, 1), b3 + hB, voffB);
            PG8_WAIT_V(6); PG8_BAR; PG8_MMA(1, 1, At, B1); PG8_BAR;
            }
        }
        PG8_ST(2 + 2 * ui);
        if constexpr (ALIGN_EPI) { if (wr == 0) PG8_BAR; }
        E(acc, cur, wr, wc, fr, fq);
        PG8_ST(3 + 2 * ui);
        if (!has_next) break;
#pragma unroll
        for (int a = 0; a < 2; ++a)
#pragma unroll
            for (int b = 0; b < 2; ++b)
#pragma unroll
                for (int m = 0; m < 4; ++m)
#pragma unroll
                    for (int n = 0; n < 2; ++n) acc[a][b][m][n] = (acc_t){0, 0, 0, 0};
        cur = nxt; cA = nA; cB = nB; ++ui;
        if constexpr (ALIGN_EPI) { if (wr == 1) PG8_BAR; }
    }
    PG8_WAIT_V(0);
    if constexpr (!ALIGN_EPI) { if (wr == 0) PG8_BAR; }
    PG8_BAR;
#undef PG8_ST
#undef PG8_SA
#undef PG8_SB
#undef PG8_STAGE
#undef PG8_LDA
#undef PG8_LDB
#undef PG8_MMA
#undef PG8_WAIT_V
#undef PG8_WAIT_L
#undef PG8_BAR
#undef PG8_SCHED
}
}

constexpr int NWAVES = 8, NTHR = 512;
constexpr int D = 4096, FF = 11008, MX = 16384, MP = 16640, NPX = 64, NPP = 65;
constexpr int DR = 2048, DS = 2048, NG = 128, SL = 16  , NCHX = 1024, NCHP = 1040, UK = 384  ;
constexpr int NSEG = 32, SEGL = 128;
constexpr float EPS = 1e-6f;
constexpr int N_PHASES = 15;

constexpr size_t MiB = 1u << 20;
constexpr size_t CTL_ZERO_BYTES = 2 * MiB;
constexpr size_t al(size_t x) { return (x + MiB - 1) / MiB * MiB; }
constexpr size_t WS_CTL = 0;
constexpr size_t WS_W1GU = al(WS_CTL + CTL_ZERO_BYTES);
constexpr size_t WS_W1D  = al(WS_W1GU + (size_t)2 * FF * D * 2);
constexpr size_t WS_WIN  = al(WS_W1D + (size_t)D * FF * 2);
constexpr size_t WS_WRG  = al(WS_WIN + (size_t)6144 * D * 2);
constexpr size_t WS_WGLU = al(WS_WRG + (size_t)4096 * 256 * 2);
constexpr size_t WS_WOUT = al(WS_WGLU + (size_t)DS * DS * 2);
constexpr size_t WS_S5TQ = al(WS_WOUT + (size_t)D * D * 2);
constexpr size_t WS_S5P  = al(WS_S5TQ + (size_t)NG * 256 * UK * 2);
constexpr size_t WS_S5BB = al(WS_S5P + (size_t)NG * 256 * 256 * 2);
constexpr size_t WS_S5LAM = al(WS_S5BB + (size_t)NG * 64 * 16 * 2 * 4);
constexpr size_t WS_SEG  = al(WS_S5LAM + (size_t)NG * 64 * 4 * 4);
constexpr size_t WS_C8   = al(WS_SEG + (size_t)2 * 4 * NSEG * DR * 4);
constexpr size_t WS_SW   = al(WS_C8 + (size_t)DR * 4);
constexpr size_t WS_H0M  = al(WS_SW + MiB);
constexpr size_t WS_AX   = al(WS_H0M + (size_t)256 * D * 4);
constexpr size_t WS_AX2  = al(WS_AX + (size_t)MP * D * 2);
constexpr size_t WS_H    = al(WS_AX2 + (size_t)MP * D * 2);
constexpr size_t WS_HB   = al(WS_H + (size_t)MP * FF * 2);
constexpr size_t WS_END  = al(WS_HB + (size_t)MP * D * 2);
constexpr size_t WS_GG   = WS_H;
constexpr size_t WS_U    = al(WS_GG + (size_t)MP * DR * 2);
constexpr size_t WS_XCB  = al(WS_U + (size_t)NG * NCHP * UK * 2);
constexpr size_t WS_Z    = al(WS_XCB + (size_t)MP * DR * 2);
static_assert(WS_Z + (size_t)MX * DS * 2 <= WS_HB, "mixer overlays fit in H");
constexpr size_t DO_UA = 0, DO_URG = al((size_t)MP * DR * 2), DO_E = al(DO_URG + (size_t)MP * DR * 2);
static_assert(DO_E + (size_t)NG * NCHX * 128 * 4 <= (size_t)MX * D * 4, "d_out scratch");
constexpr int CW_BAR = 4096;
constexpr int CW_SS = 65536;
constexpr int CW_CM = CW_SS + 8 * MP + 64;
constexpr int CW_CMD = CW_CM + 4 * FF;
constexpr int CW_HM = CW_CMD + D;
static_assert((CW_HM + MX) * 4 <= (int)CTL_ZERO_BYTES && (CW_SS % 2) == 0, "ctl");

constexpr int RING_BYTES = 131072, MISC_OFF = RING_BYTES + 320, LDS_BYTES = 147456;

#define LAS __attribute__((address_space(3)))
typedef unsigned short bf16;
typedef unsigned v4u __attribute__((ext_vector_type(4)));
typedef unsigned v2u __attribute__((ext_vector_type(2)));
typedef float f32x4 __attribute__((ext_vector_type(4)));
typedef float f32x2 __attribute__((ext_vector_type(2)));
#define LDS_WAIT() asm volatile("s_waitcnt lgkmcnt(0)" ::: "memory")
#define VM_WAIT() asm volatile("s_waitcnt vmcnt(0)" ::: "memory")
using pg8::cvt_pk_bf16;
__device__ __forceinline__ float bf_lo(unsigned w) { return __uint_as_float(w << 16); }
__device__ __forceinline__ float bf_hi(unsigned w) { return __uint_as_float(w & 0xffff0000u); }
__device__ __forceinline__ float fsigmoid(float v) { return __builtin_amdgcn_rcpf(1.0f + __builtin_amdgcn_exp2f(-1.4426950408889634f * v)); }
__device__ __forceinline__ float gelu_tanh(float x) { const float u = x * (1.0f + 0.044715f * x * x); return x * fsigmoid(1.5957691216057308f * u); }
__device__ __forceinline__ float wave_sum(float v) {
#pragma unroll
    for (int o = 1; o < 64; o <<= 1) v += __shfl_xor(v, o);
    return v;
}

typedef unsigned long long u64;
__device__ __forceinline__ void ss_add(u64* p, float s) { atomicAdd(p, (u64)(s * 4294967296.0f)); }
__device__ __forceinline__ float ss_get(const u64* p) { return (float)(*p) * 2.3283064365386963e-10f; }

#define XB_TMO      128
#define XB_XCNT(j)  (256  + 64 * (j))
#define XB_XSUB(j)  (1280 + 64 * (j))
#define XB_XGEN(j)  (2304 + 64 * (j))
#define XB_TOP      3328
#define XB_TOPGEN   3392
#define XCD_BAR_WORDS 3456
#define XB_SPIN_CAP (1u << 18)
__device__ __forceinline__ unsigned xb_ld(unsigned* p)              { return __hip_atomic_load(p, __ATOMIC_RELAXED, __HIP_MEMORY_SCOPE_AGENT); }
__device__ __forceinline__ unsigned xb_add(unsigned* p, unsigned v) { return __hip_atomic_fetch_add(p, v, __ATOMIC_RELAXED, __HIP_MEMORY_SCOPE_AGENT); }
__device__ __forceinline__ unsigned xb_xcc_id() { return (unsigned)__builtin_amdgcn_s_getreg((3 << 11) | 20) & 0xFu; }
#define XB_SPIN(cond, bar) do { unsigned _sp = 0; while (cond) { __builtin_amdgcn_s_sleep(1); \
    if ((++_sp & 255u) == 0u) { if (xb_ld(&(bar)[XB_TMO])) break; if (_sp > XB_SPIN_CAP) { atomicAdd(&(bar)[XB_TMO], 1u); break; } } } } while (0)
struct XcdBarrier { unsigned* bar; unsigned x; volatile LAS unsigned* st; };
__device__ __forceinline__ XcdBarrier xcd_barrier_post(unsigned* bar, volatile LAS unsigned* st) {
    XcdBarrier b; b.bar = bar; b.x = xb_xcc_id(); b.st = st;
    if (threadIdx.x == 0) (void)xb_add(&bar[XB_XCNT(b.x)], 1u);
    return b;
}
__device__ __forceinline__ void xcd_barrier_complete(unsigned* bar, unsigned x, unsigned& nloc, unsigned& nx) {
    const unsigned G = gridDim.x * gridDim.y * gridDim.z;
    unsigned sum, cnt, mine, sp = 0u;
    for (;;) {
        sum = 0u; cnt = 0u; mine = 0u;
#pragma unroll
        for (unsigned j = 0; j < 16; ++j) { const unsigned c = xb_ld(&bar[XB_XCNT(j)]); sum += c; cnt += (c > 0u) ? 1u : 0u; mine = (j == x) ? c : mine; }
        if (sum == G) break;
        __builtin_amdgcn_s_sleep(1);
        if ((++sp & 255u) == 0u) { if (xb_ld(&bar[XB_TMO])) break; if (sp > XB_SPIN_CAP) { atomicAdd(&bar[XB_TMO], 1u); break; } }
    }
    nloc = mine > 0u ? mine : 1u; nx = cnt > 0u ? cnt : 1u;
}
__device__ __forceinline__ void xcd_barrier(const XcdBarrier& b) {
    asm volatile("s_waitcnt vmcnt(0)" ::: "memory");
    __syncthreads();
    if (threadIdx.x == 0) {
        unsigned* bar = b.bar;
        __builtin_amdgcn_s_waitcnt(0);
        unsigned nloc = b.st[0], nx = b.st[1];
        if (nloc == 0u) { xcd_barrier_complete(bar, b.x, nloc, nx); b.st[0] = nloc; b.st[1] = nx; }
        const unsigned old = xb_add(&bar[XB_XSUB(b.x)], 1u);
        const unsigned gen = old / nloc;
        if (old + 1u == (gen + 1u) * nloc) {
            __builtin_amdgcn_fence(__ATOMIC_RELEASE, "agent");
            asm volatile("s_waitcnt vmcnt(0)" ::: "memory");
            const unsigned og = xb_add(&bar[XB_TOP], 1u);
            const unsigned tg = og / nx;
            if (og + 1u == (tg + 1u) * nx) xb_add(&bar[XB_TOPGEN], 1u);
            else XB_SPIN(xb_ld(&bar[XB_TOPGEN]) == tg, bar);
            __builtin_amdgcn_fence(__ATOMIC_ACQUIRE, "agent");
            xb_add(&bar[XB_XGEN(b.x)], 1u);
            asm volatile("s_waitcnt vmcnt(0)" ::: "memory");
        } else {
            XB_SPIN(xb_ld(&bar[XB_XGEN(b.x)]) == gen, bar);
            __builtin_amdgcn_fence(__ATOMIC_ACQUIRE, "agent");
            asm volatile("s_waitcnt vmcnt(0)" ::: "memory");
        }
    }
    __syncthreads();
}

using pg8::Unit;
#define EPI_ARGS const f32x4 (&acc)[2][2][4][2], const Unit& u, int wr, int wc, int fr, int fq
#define ROWLOOP _Pragma("unroll") for (int ai = 0; ai < 2; ++ai) _Pragma("unroll") for (int m = 0; m < 4; ++m)

template <bool RS> struct EpiSwiglu {
    bf16* H; const u64* ss;
    __device__ __forceinline__ void operator()(EPI_ARGS) const {
        const int row0 = u.pm * 256 + wr * 64 + fr, j0 = u.pn * 128 + wc * 32 + 8 * fq;
        ROWLOOP { const int row = row0 + ai * 128 + m * 16;
            float rs = 1.0f; if (RS) rs = __builtin_amdgcn_rsqf(ss_get(ss + row) * (1.0f / D) + EPS);
            float h[8];
#pragma unroll
            for (int n = 0; n < 2; ++n)
#pragma unroll
                for (int e = 0; e < 4; ++e) { const float gv = acc[ai][0][m][n][e] * rs, uv = acc[ai][1][m][n][e] * rs; h[n * 4 + e] = gv * uv * fsigmoid(gv); }
            v4u w; w.x = cvt_pk_bf16(h[0], h[1]); w.y = cvt_pk_bf16(h[2], h[3]); w.z = cvt_pk_bf16(h[4], h[5]); w.w = cvt_pk_bf16(h[6], h[7]);
            *(v4u*)(H + (size_t)row * FF + j0) = w; }
    }
};
#define EPI_ARGS_I8 const pg8::i32x4 (&acc)[2][2][4][2], const Unit& u, int wr, int wc, int fr, int fq
template <bool RS> struct EpiSwigluI8 {
    bf16* H; const float* sa; const u64* ss; const float* sw; unsigned* hmax;
    __device__ __forceinline__ void operator()(EPI_ARGS_I8) const {
        const int row0 = u.pm * 256 + wr * 64 + fr, j0 = u.pn * 128 + wc * 32 + 8 * fq, b0 = u.pn * 256 + wc * 32 + 8 * fq;
        const f32x4 sg0 = *(const f32x4*)(sw + b0), sg1 = *(const f32x4*)(sw + b0 + 4), su0 = *(const f32x4*)(sw + b0 + 128), su1 = *(const f32x4*)(sw + b0 + 132);
        ROWLOOP { const int row = row0 + ai * 128 + m * 16;
            float rs = sa[row]; if (RS) rs *= __builtin_amdgcn_rsqf(ss_get(ss + row) * (1.0f / D) + EPS);
            float h[8];
#pragma unroll
            for (int e = 0; e < 4; ++e) { { const float gv = (float)acc[ai][0][m][0][e] * rs * sg0[e], uv = (float)acc[ai][1][m][0][e] * rs * su0[e]; h[e] = gv * uv * fsigmoid(gv); }
                                          { const float gv = (float)acc[ai][0][m][1][e] * rs * sg1[e], uv = (float)acc[ai][1][m][1][e] * rs * su1[e]; h[4 + e] = gv * uv * fsigmoid(gv); } }
            v4u w; w.x = cvt_pk_bf16(h[0], h[1]); w.y = cvt_pk_bf16(h[2], h[3]); w.z = cvt_pk_bf16(h[4], h[5]); w.w = cvt_pk_bf16(h[6], h[7]);
            *(v4u*)(H + (size_t)row * FF + j0) = w;
            if (hmax) { float mx = fmaxf(fmaxf(fmaxf(fabsf(h[0]), fabsf(h[1])), fmaxf(fabsf(h[2]), fabsf(h[3]))), fmaxf(fmaxf(fabsf(h[4]), fabsf(h[5])), fmaxf(fabsf(h[6]), fabsf(h[7]))));
                mx = fmaxf(mx, __shfl_xor(mx, 16)); mx = fmaxf(mx, __shfl_xor(mx, 32)); if (fq == 0) atomicMax(hmax + row, __float_as_uint(mx)); } }
    }
};
template <bool BASE_F32, bool FINAL> struct EpiResidB {
    const void* base; bf16* out; const float* gain; u64* ss;
    __device__ __forceinline__ void operator()(EPI_ARGS) const {
        const int row0 = u.pm * 256 + wr * 64 + fr;
        float sq[2][4];
        ROWLOOP sq[ai][m] = 0.f;
#pragma unroll
        for (int bj = 0; bj < 2; ++bj) { const int c0 = u.pn * 256 + bj * 128 + wc * 32 + 8 * fq;
            f32x4 g0 = {1.f, 1.f, 1.f, 1.f}, g1 = g0; if (FINAL) { g0 = *(const f32x4*)(gain + c0); g1 = *(const f32x4*)(gain + c0 + 4); }
#pragma unroll
            for (int ai = 0; ai < 2; ++ai) { f32x4 bq[4][2];
#pragma unroll
            for (int m = 0; m < 4; ++m) { const size_t off = (size_t)(row0 + ai * 128 + m * 16) * D + c0;
                if (BASE_F32) { bq[m][0] = *(const f32x4*)((const float*)base + off); bq[m][1] = *(const f32x4*)((const float*)base + off + 4); }
                else { const v4u w = *(const v4u*)((const bf16*)base + off); bq[m][0] = (f32x4){bf_lo(w.x), bf_hi(w.x), bf_lo(w.y), bf_hi(w.y)}; bq[m][1] = (f32x4){bf_lo(w.z), bf_hi(w.z), bf_lo(w.w), bf_hi(w.w)}; } }
#pragma unroll
            for (int m = 0; m < 4; ++m) { const size_t off = (size_t)(row0 + ai * 128 + m * 16) * D + c0;
                const f32x4 v0 = bq[m][0] + acc[ai][bj][m][0], v1 = bq[m][1] + acc[ai][bj][m][1];
                sq[ai][m] += (v0[0] * v0[0] + v0[1] * v0[1]) + (v0[2] * v0[2] + v0[3] * v0[3]) + (v1[0] * v1[0] + v1[1] * v1[1]) + (v1[2] * v1[2] + v1[3] * v1[3]);
                const f32x4 w0 = v0 * g0, w1 = v1 * g1;
                v4u w; w.x = cvt_pk_bf16(w0[0], w0[1]); w.y = cvt_pk_bf16(w0[2], w0[3]); w.z = cvt_pk_bf16(w1[0], w1[1]); w.w = cvt_pk_bf16(w1[2], w1[3]); *(v4u*)(out + off) = w; } } }
        ROWLOOP { float s = sq[ai][m]; s += __shfl_xor(s, 16); s += __shfl_xor(s, 32);
            if (fq == 0) ss_add(ss + row0 + ai * 128 + m * 16, s); }
    }
};
struct EpiResidI8 {
    const bf16* base; bf16* out; const float* gain; u64* ss; const float* sh; const float* sw;
    __device__ __forceinline__ void operator()(EPI_ARGS_I8) const {
        const int row0 = u.pm * 256 + wr * 64 + fr;
        float sq[2][4], rsc[2][4];
        ROWLOOP { sq[ai][m] = 0.f; rsc[ai][m] = sh[row0 + ai * 128 + m * 16]; }
#pragma unroll
        for (int bj = 0; bj < 2; ++bj) { const int c0 = u.pn * 256 + bj * 128 + wc * 32 + 8 * fq;
            const f32x4 g0 = *(const f32x4*)(gain + c0), g1 = *(const f32x4*)(gain + c0 + 4), s0 = *(const f32x4*)(sw + c0), s1 = *(const f32x4*)(sw + c0 + 4);
#pragma unroll
            for (int ai = 0; ai < 2; ++ai) { v4u bq[4];
#pragma unroll
            for (int m = 0; m < 4; ++m) bq[m] = *(const v4u*)(base + (size_t)(row0 + ai * 128 + m * 16) * D + c0);
#pragma unroll
            for (int m = 0; m < 4; ++m) { const size_t off = (size_t)(row0 + ai * 128 + m * 16) * D + c0; const v4u w = bq[m]; const float r = rsc[ai][m];
                const f32x4 b0 = {bf_lo(w.x), bf_hi(w.x), bf_lo(w.y), bf_hi(w.y)}, b1 = {bf_lo(w.z), bf_hi(w.z), bf_lo(w.w), bf_hi(w.w)};
                f32x4 v0, v1;
#pragma unroll
                for (int e = 0; e < 4; ++e) { v0[e] = b0[e] + (float)acc[ai][bj][m][0][e] * r * s0[e]; v1[e] = b1[e] + (float)acc[ai][bj][m][1][e] * r * s1[e]; }
                sq[ai][m] += (v0[0] * v0[0] + v0[1] * v0[1]) + (v0[2] * v0[2] + v0[3] * v0[3]) + (v1[0] * v1[0] + v1[1] * v1[1]) + (v1[2] * v1[2] + v1[3] * v1[3]);
                const f32x4 w0 = v0 * g0, w1 = v1 * g1;
                v4u o; o.x = cvt_pk_bf16(w0[0], w0[1]); o.y = cvt_pk_bf16(w0[2], w0[3]); o.z = cvt_pk_bf16(w1[0], w1[1]); o.w = cvt_pk_bf16(w1[2], w1[3]); *(v4u*)(out + off) = o; } } }
        ROWLOOP { float s = sq[ai][m]; s += __shfl_xor(s, 16); s += __shfl_xor(s, 32);
            if (fq == 0) ss_add(ss + row0 + ai * 128 + m * 16, s); }
    }
};
struct EpiWin {
    const u64* ss; bf16* urg; bf16* gg; bf16* U;
    __device__ __forceinline__ void operator()(EPI_ARGS) const {
        const int row0 = u.pm * 256 + wr * 64 + fr;
        ROWLOOP { const int row = row0 + ai * 128 + m * 16;
            const float rs = __builtin_amdgcn_rsqf(ss_get(ss + row) * (1.0f / D) + EPS);
#pragma unroll
            for (int bj = 0; bj < 2; ++bj) { const int c0 = u.pn * 256 + bj * 128 + wc * 32 + 8 * fq;
                const f32x4 v0 = acc[ai][bj][m][0] * rs, v1 = acc[ai][bj][m][1] * rs;
                if (u.pn < 8) { v4u w; w.x = cvt_pk_bf16(v0[0], v0[1]); w.y = cvt_pk_bf16(v0[2], v0[3]); w.z = cvt_pk_bf16(v1[0], v1[1]); w.w = cvt_pk_bf16(v1[2], v1[3]); *(v4u*)(urg + (size_t)row * DR + c0) = w; }
                else if (u.pn < 16) { v4u w; w.x = cvt_pk_bf16(gelu_tanh(v0[0]), gelu_tanh(v0[1])); w.y = cvt_pk_bf16(gelu_tanh(v0[2]), gelu_tanh(v0[3]));
                    w.z = cvt_pk_bf16(gelu_tanh(v1[0]), gelu_tanh(v1[1])); w.w = cvt_pk_bf16(gelu_tanh(v1[2]), gelu_tanh(v1[3])); *(v4u*)(gg + (size_t)row * DR + (c0 - 2048)) = w; }
                else { const int cs = c0 - 4096, g = cs >> 4, cp = cs & 15;
                    v4u w; w.x = cvt_pk_bf16(v0[0], v0[1]); w.y = cvt_pk_bf16(v0[2], v0[3]); w.z = cvt_pk_bf16(v1[0], v1[1]); w.w = cvt_pk_bf16(v1[2], v1[3]);
                    *(v4u*)(U + ((size_t)g * NCHP + (row >> 4)) * UK + (row & 15) * 16 + cp) = w; } } }
    }
};
__device__ __forceinline__ float one_minus_exp(float x) {
    const float big = 1.0f - __builtin_amdgcn_exp2f(1.4426950408889634f * x);
    const float small = -x * (1.0f + x * (0.5f + x * (0.16666667f + x * 0.041666668f)));
    return (x > -0.0625f) ? small : big;
}
struct EpiGates {
    const float* b_a; const float* b_x; const float* c8t; const bf16* xcb; bf16* LA; bf16* BX;
    __device__ __forceinline__ void operator()(EPI_ARGS) const {
        const int row0 = u.pm * 256 + wr * 64 + fr, ch0 = (u.pn >> 1) * 256 + (u.pn & 1) * 128 + wc * 32 + 8 * fq;
        const f32x4 ba0 = *(const f32x4*)(b_a + ch0), ba1 = *(const f32x4*)(b_a + ch0 + 4), bx0 = *(const f32x4*)(b_x + ch0), bx1 = *(const f32x4*)(b_x + ch0 + 4);
        const f32x4 c80 = *(const f32x4*)(c8t + ch0), c81 = *(const f32x4*)(c8t + ch0 + 4);
        v4u xq[2][4];
        ROWLOOP xq[ai][m] = *(const v4u*)(xcb + (size_t)(row0 + ai * 128 + m * 16) * DR + ch0);
        ROWLOOP { const size_t off = (size_t)(row0 + ai * 128 + m * 16) * DR + ch0; const v4u xw = xq[ai][m];
            const f32x4 x0 = {bf_lo(xw.x), bf_hi(xw.x), bf_lo(xw.y), bf_hi(xw.y)}, x1 = {bf_lo(xw.z), bf_hi(xw.z), bf_lo(xw.w), bf_hi(xw.w)};
            f32x4 l0, l1;
#pragma unroll
            for (int e = 0; e < 4; ++e) { l0[e] = c80[e] * fsigmoid(acc[ai][0][m][0][e] + ba0[e]); l1[e] = c81[e] * fsigmoid(acc[ai][0][m][1][e] + ba1[e]); }
            v4u lw; lw.x = cvt_pk_bf16(l0[0], l0[1]); lw.y = cvt_pk_bf16(l0[2], l0[3]); lw.z = cvt_pk_bf16(l1[0], l1[1]); lw.w = cvt_pk_bf16(l1[2], l1[3]);
            const f32x4 r0 = {bf_lo(lw.x), bf_hi(lw.x), bf_lo(lw.y), bf_hi(lw.y)}, r1 = {bf_lo(lw.z), bf_hi(lw.z), bf_lo(lw.w), bf_hi(lw.w)};
            f32x4 o0, o1;
#pragma unroll
            for (int e = 0; e < 4; ++e) { o0[e] = __builtin_amdgcn_sqrtf(one_minus_exp(2.0f * r0[e])) * fsigmoid(acc[ai][1][m][0][e] + bx0[e]) * x0[e];
                                          o1[e] = __builtin_amdgcn_sqrtf(one_minus_exp(2.0f * r1[e])) * fsigmoid(acc[ai][1][m][1][e] + bx1[e]) * x1[e]; }
            v4u ow; ow.x = cvt_pk_bf16(o0[0], o0[1]); ow.y = cvt_pk_bf16(o0[2], o0[3]); ow.z = cvt_pk_bf16(o1[0], o1[1]); ow.w = cvt_pk_bf16(o1[2], o1[3]);
            *(v4u*)(LA + off) = lw; *(v4u*)(BX + off) = ow; }
    }
};
struct EpiS5E {
    float* E;
    __device__ __forceinline__ void operator()(EPI_ARGS) const {
        const int row0 = u.pm * 256 + wr * 64 + fr, c0 = wc * 32 + 8 * fq;
        ROWLOOP { float* p = E + ((size_t)u.pn * NCHX + row0 + ai * 128 + m * 16) * 128 + c0; *(f32x4*)p = acc[ai][0][m][0]; *(f32x4*)(p + 4) = acc[ai][0][m][1]; }
    }
};
struct EpiS5Y {
    bf16* Z;
    __device__ __forceinline__ void operator()(EPI_ARGS) const {
        const int row0 = u.pm * 256 + wr * 64 + fr;
        ROWLOOP { const int j = row0 + ai * 128 + m * 16;
#pragma unroll
            for (int bj = 0; bj < 2; ++bj) { const int col = bj * 128 + wc * 32 + 8 * fq, t = col >> 4, cp = col & 15;
                const f32x4 v0 = acc[ai][bj][m][0], v1 = acc[ai][bj][m][1];
                v4u w; w.x = cvt_pk_bf16(gelu_tanh(v0[0]), gelu_tanh(v0[1])); w.y = cvt_pk_bf16(gelu_tanh(v0[2]), gelu_tanh(v0[3]));
                w.z = cvt_pk_bf16(gelu_tanh(v1[0]), gelu_tanh(v1[1])); w.w = cvt_pk_bf16(gelu_tanh(v1[2]), gelu_tanh(v1[3]));
                *(v4u*)(Z + (size_t)(j * 16 + t) * DS + u.pn * 16 + cp) = w; } }
    }
};
struct EpiGlu {
    const bf16* Z; const float* bias; const float* gain; bf16* AO; u64* ss;
    __device__ __forceinline__ void operator()(EPI_ARGS) const {
        const int row0 = u.pm * 256 + wr * 64 + fr;
        float sq[2][4];
        ROWLOOP sq[ai][m] = 0.f;
#pragma unroll
        for (int bj = 0; bj < 2; ++bj) { const int c0 = u.pn * 256 + bj * 128 + wc * 32 + 8 * fq;
            const f32x4 b0 = *(const f32x4*)(bias + c0), b1 = *(const f32x4*)(bias + c0 + 4), g0 = *(const f32x4*)(gain + c0), g1 = *(const f32x4*)(gain + c0 + 4);
            v4u zq[2][4];
            ROWLOOP zq[ai][m] = *(const v4u*)(Z + (size_t)(row0 + ai * 128 + m * 16) * DS + c0);
            ROWLOOP { const int row = row0 + ai * 128 + m * 16;
                const v4u zw = zq[ai][m];
                const f32x4 z0 = {bf_lo(zw.x), bf_hi(zw.x), bf_lo(zw.y), bf_hi(zw.y)}, z1 = {bf_lo(zw.z), bf_hi(zw.z), bf_lo(zw.w), bf_hi(zw.w)};
                f32x4 y0, y1;
#pragma unroll
                for (int e = 0; e < 4; ++e) { y0[e] = z0[e] * fsigmoid(acc[ai][bj][m][0][e] + b0[e]); y1[e] = z1[e] * fsigmoid(acc[ai][bj][m][1][e] + b1[e]); }
                sq[ai][m] += (y0[0] * y0[0] + y0[1] * y0[1]) + (y0[2] * y0[2] + y0[3] * y0[3]) + (y1[0] * y1[0] + y1[1] * y1[1]) + (y1[2] * y1[2] + y1[3] * y1[3]);
                const f32x4 w0 = y0 * g0, w1 = y1 * g1;
                v4u w; w.x = cvt_pk_bf16(w0[0], w0[1]); w.y = cvt_pk_bf16(w0[2], w0[3]); w.z = cvt_pk_bf16(w1[0], w1[1]); w.w = cvt_pk_bf16(w1[2], w1[3]);
                *(v4u*)(AO + (size_t)row * D + c0) = w; } }
        ROWLOOP { float s = sq[ai][m]; s += __shfl_xor(s, 16); s += __shfl_xor(s, 32);
            if (fq == 0) ss_add(ss + row0 + ai * 128 + m * 16, s); }
    }
};

struct Args { const float* in[33]; float* out; unsigned char* ws; int ph_lo, ph_hi; };
enum { I_X = 0, I_META, I_N1, I_WG1, I_WU1, I_WD1, I_NMIX, I_WIN, I_CONVW, I_CONVB, I_WA, I_BA, I_WX, I_BX, I_LAM, I_S5LRE, I_S5LIM, I_S5LDT, I_S5BRE, I_S5BIM, I_S5CRE, I_S5CIM,
       I_S5D, I_GLUW, I_GLUB, I_NRG, I_NS5, I_WOUT, I_N2, I_WG2, I_WU2, I_WD2, I_NFIN };

struct CvtJob { const float* W; int N; bf16* WT; int ldk, k0, n0, dest_row0; const float* gk; float wscale; };
__device__ __forceinline__ void cvt_load(const CvtJob& j, float (&v)[32], int lane) {
#pragma unroll
    for (int i = 0; i < 32; ++i) v[i] = j.W[(size_t)(j.k0 + 2 * i + (lane >> 5)) * j.N + j.n0 + (lane & 31)];
    if (j.gk) {
#pragma unroll
        for (int i = 0; i < 32; ++i) v[i] *= j.gk[2 * i + (lane >> 5)]; }
    if (j.wscale != 1.0f) {
#pragma unroll
        for (int i = 0; i < 32; ++i) v[i] *= j.wscale; }
}
__device__ __forceinline__ void cvt_to_lds(const float (&v)[32], LAS float* scr, int lane) {
#pragma unroll
    for (int i = 0; i < 32; ++i) scr[(2 * i + (lane >> 5)) * 33 + (lane & 31)] = v[i];
}
__device__ __forceinline__ void cvt_store(const CvtJob& j, LAS float* scr, int lane) {
    LDS_WAIT(); asm volatile("" ::: "memory");
    const int c = lane & 7;
#pragma unroll
    for (int q = 0; q < 4; ++q) { const int n = (lane >> 3) + 8 * q; const LAS float* s = scr + (8 * c) * 33 + n;
        v4u o; o.x = cvt_pk_bf16(s[0 * 33], s[1 * 33]); o.y = cvt_pk_bf16(s[2 * 33], s[3 * 33]); o.z = cvt_pk_bf16(s[4 * 33], s[5 * 33]); o.w = cvt_pk_bf16(s[6 * 33], s[7 * 33]);
        *(v4u*)(j.WT + (size_t)(j.dest_row0 + n) * j.ldk + j.k0 + 8 * c) = o; }
    LDS_WAIT(); asm volatile("" ::: "memory");
}
template <int MODE> __device__ __forceinline__ CvtJob cvt_job(const float* W, int K, int N, bf16* WT, int it, const float* gk, float wscale) {
    const int nblk = N / 32, kb = it / nblk, nb = it % nblk, k0 = kb * 64, n0 = nb * 32; const float* g = gk ? gk + k0 : nullptr;
    if (MODE == 3) return CvtJob{W + (size_t)k0 * N, N, WT + (k0 + K / 2) % K, K, 0, n0, n0, g, wscale};
    if (MODE == 0) return CvtJob{W, N, WT, K, k0, n0, n0, g, wscale};
    return CvtJob{W, N, WT, K, k0, n0, (n0 >> 7) * 256 + (MODE - 1) * 128 + (n0 & 127), g, wscale};
}
template <int MODE> __device__ __forceinline__ void cvt_matrix(const float* W, int K, int N, bf16* WT, LAS float* scr, int gw, int NGW, int lane, const float* gk = nullptr, float wscale = 1.0f) {
    const int nit = (K / 64) * (N / 32);
    int it = gw; if (it >= nit) return;
    float v[32]; CvtJob cur = cvt_job<MODE>(W, K, N, WT, it, gk, wscale); cvt_load(cur, v, lane);
    for (;;) {
        cvt_to_lds(v, scr, lane);
        const int nx = it + NGW; const bool more = nx < nit; CvtJob nxt = cur;
        if (more) { nxt = cvt_job<MODE>(W, K, N, WT, nx, gk, wscale); cvt_load(nxt, v, lane); }
        cvt_store(cur, scr, lane);
        if (!more) break;
        it = nx; cur = nxt;
    }
}
__device__ __forceinline__ void cvt_item(const float* W, int N, bf16* WT, int ldk, int k0, int n0, int dest_row0, LAS float* scr, int lane) {
    const CvtJob j{W, N, WT, ldk, k0, n0, dest_row0, nullptr, 1.0f}; float v[32]; cvt_load(j, v, lane); cvt_to_lds(v, scr, lane); cvt_store(j, scr, lane);
}

__device__ __forceinline__ int q127(float v) { return __float2int_rn(__builtin_amdgcn_fmed3f(v, -127.0f, 127.0f)); }
__device__ __forceinline__ unsigned pack_i8x4(float a, float b, float c, float d) {
    return ((unsigned)q127(a) & 255u) | (((unsigned)q127(b) & 255u) << 8) | (((unsigned)q127(c) & 255u) << 16) | ((unsigned)q127(d) << 24); }
__device__ __forceinline__ void colmax_matrix(const float* W, int K, int N, const float* gk, unsigned* cm, int gw, int NGW, int lane) {
    const int nblk = N / 256, nit = (K / 64) * nblk;
    for (int it = gw; it < nit; it += NGW) { const int kb = it / nblk, nb = it % nblk, n = nb * 256 + 4 * lane; f32x4 mx = {0.f, 0.f, 0.f, 0.f};
        for (int k0 = kb * 64; k0 < kb * 64 + 64; k0 += 16) { f32x4 v[16];
#pragma unroll
            for (int j = 0; j < 16; ++j) v[j] = *(const f32x4*)(W + (size_t)(k0 + j) * N + n);
#pragma unroll
            for (int j = 0; j < 16; ++j) { const float gg = gk ? gk[k0 + j] : 1.0f;
#pragma unroll
                for (int e = 0; e < 4; ++e) mx[e] = fmaxf(mx[e], fabsf(v[j][e] * gg)); } }
#pragma unroll
        for (int e = 0; e < 4; ++e) atomicMax(cm + n + e, __float_as_uint(mx[e])); }
}
__device__ __forceinline__ void quant_gu_matrix(const float* W, int K, int N, const float* gk, const unsigned* cm, unsigned char* WT, float* sw, int half_gu, LAS unsigned* scr, int gw, int NGW, int lane, float sscale = 1.0f) {
    const int nblk = N / 32, nit = (K / 128) * nblk, hl = lane >> 5, nl = lane & 31;
    for (int it = gw; it < nit; it += NGW) { const int kb = it / nblk, nb = it % nblk, k0 = kb * 128, n0 = nb * 32, drow0 = (half_gu < 0) ? n0 : (n0 >> 7) * 256 + half_gu * 128 + (n0 & 127);
        const float cmx = __uint_as_float(cm[n0 + nl]), inv = cmx > 0.f ? 127.0f / cmx : 0.f;
        if (kb == 0 && hl == 0) sw[drow0 + nl] = cmx * (sscale / 127.0f);
        float v[16][4];
#pragma unroll
        for (int j = 0; j < 16; ++j)
#pragma unroll
            for (int e = 0; e < 4; ++e) v[j][e] = W[(size_t)(k0 + 8 * j + 4 * hl + e) * N + n0 + nl];
        if (gk) {
#pragma unroll
            for (int j = 0; j < 16; ++j)
#pragma unroll
                for (int e = 0; e < 4; ++e) v[j][e] *= gk[k0 + 8 * j + 4 * hl + e]; }
#pragma unroll
        for (int j = 0; j < 16; ++j) scr[nl * 33 + 2 * j + hl] = pack_i8x4(v[j][0] * inv, v[j][1] * inv, v[j][2] * inv, v[j][3] * inv);
        LDS_WAIT(); asm volatile("" ::: "memory");
#pragma unroll
        for (int q = 0; q < 4; ++q) { const int r = (lane >> 3) + 8 * q, pc = lane & 7; const LAS unsigned* sp = scr + r * 33 + 4 * pc;
            v4u o; o.x = sp[0]; o.y = sp[1]; o.z = sp[2]; o.w = sp[3];
            *(v4u*)(WT + (size_t)(drow0 + r) * K + k0 + 16 * pc) = o; }
        LDS_WAIT(); asm volatile("" ::: "memory"); }
}

struct Ctx { LAS unsigned char* lds; int wave, vcu, G; };
#define PHASE_IDS const int lane_ = pg8::lane_id_opaque(); const int tid_ = F.wave * 64 + lane_;

__device__ __forceinline__ void s5_tables(const Args& a, const Ctx& F, int g, int hv) {
    PHASE_IDS
    LAS f32x2* pw = (LAS f32x2*)(F.lds);
    LAS f32x2* bb = (LAS f32x2*)(F.lds + 8704);
    LAS f32x2* cc = (LAS f32x2*)(F.lds + 8704 + 8192);
    LAS float* Kt = (LAS float*)(F.lds + 8704 + 16384);
    LAS f32x2* qn = (LAS f32x2*)(F.lds + 8704 + 32768);
    const float dt = expf(a.in[I_S5LDT][g]);
    const float* lre = a.in[I_S5LRE] + g * 64; const float* lim = a.in[I_S5LIM] + g * 64;
    float* BBg = (float*)(a.ws + WS_S5BB); float* LAMg = (float*)(a.ws + WS_S5LAM);
    if (tid_ < 64) { const int n = tid_; const float x = lre[n] * dt, th = lim[n] * dt, mag = expf(x), e1 = expm1f(x); float sn, co; sincosf(th, &sn, &co); const float sh = sinf(0.5f * th);
        const float lr = mag * co, li = mag * sn; float pr = 1.f, pi = 0.f;
#pragma unroll
        for (int tau = 0; tau <= 16; ++tau) { pw[tau * 64 + n] = (f32x2){pr, pi}; if (tau == 1 && hv == 0) { LAMg[(size_t)(g * 64 + n) * 4] = pr; LAMg[(size_t)(g * 64 + n) * 4 + 1] = pi; }
            if (tau == 16 && hv == 0) { LAMg[(size_t)(g * 64 + n) * 4 + 2] = pr; LAMg[(size_t)(g * 64 + n) * 4 + 3] = pi; }
            const float nr = pr * lr - pi * li, ni = pr * li + pi * lr; pr = nr; pi = ni; }
        const float nr = e1 * co - 2.0f * sh * sh, ni = (e1 + 1.0f) * sn;
        const float ar = lre[n], ai = lim[n], den = 1.0f / (ar * ar + ai * ai);
        qn[n] = (f32x2){(nr * ar + ni * ai) * den, (ni * ar - nr * ai) * den}; }
    for (int idx = tid_; idx < 16 * 64; idx += NTHR) { const int c = idx >> 6, n = idx & 63; cc[idx] = (f32x2){a.in[I_S5CRE][(g * 16 + c) * 64 + n], a.in[I_S5CIM][(g * 16 + c) * 64 + n]}; }
    __syncthreads();
    for (int idx = tid_; idx < 64 * 16; idx += NTHR) { const int n = idx >> 4, c = idx & 15; const f32x2 q = qn[n];
        const float br = a.in[I_S5BRE][(g * 64 + n) * 16 + c], bi = a.in[I_S5BIM][(g * 64 + n) * 16 + c];
        const f32x2 v = {q.x * br - q.y * bi, q.x * bi + q.y * br};
        bb[idx] = v; if (hv == 0) *(f32x2*)(BBg + ((size_t)(g * 64 + n) * 16 + c) * 2) = v; }
    __syncthreads();
    { const int tau = tid_ >> 5, c = 8 * hv + ((tid_ >> 2) & 7), cq = tid_ & 3; float k4[4] = {0.f, 0.f, 0.f, 0.f};
        for (int n = 0; n < 64; ++n) { const f32x2 C = cc[c * 64 + n], P = pw[tau * 64 + n]; const float qr = C.x * P.x - C.y * P.y, qi = C.x * P.y + C.y * P.x;
#pragma unroll
            for (int e = 0; e < 4; ++e) { const f32x2 B = bb[n * 16 + 4 * cq + e]; k4[e] += qr * B.x - qi * B.y; } }
#pragma unroll
        for (int e = 0; e < 4; ++e) { if (tau == 0 && c == 4 * cq + e) k4[e] += a.in[I_S5D][g * 16 + c]; Kt[(tau * 16 + c) * 16 + 4 * cq + e] = k4[e]; } }
    __syncthreads();
    bf16* TQ = (bf16*)(a.ws + WS_S5TQ) + (size_t)g * 256 * UK; bf16* PP = (bf16*)(a.ws + WS_S5P) + (size_t)g * 256 * 256;
    for (int idx = tid_; idx < 128 * 48; idx += NTHR) { const int rr = idx / 48, kc = idx % 48, t = rr >> 3, c = 8 * hv + (rr & 7), rho = t * 16 + c; float v[8];
        if (kc < 32) { const int sx = kc >> 1, cp0 = (kc & 1) * 8;
#pragma unroll
            for (int e = 0; e < 8; ++e) v[e] = (t >= sx) ? Kt[((t - sx) * 16 + c) * 16 + cp0 + e] : 0.f; }
        else { const int n0 = (kc - 32) * 4;
#pragma unroll
            for (int e = 0; e < 4; ++e) { const f32x2 C = cc[c * 64 + n0 + e], P = pw[(t + 1) * 64 + n0 + e]; v[2 * e] = C.x * P.x - C.y * P.y; v[2 * e + 1] = -(C.x * P.y + C.y * P.x); } }
        v4u w; w.x = cvt_pk_bf16(v[0], v[1]); w.y = cvt_pk_bf16(v[2], v[3]); w.z = cvt_pk_bf16(v[4], v[5]); w.w = cvt_pk_bf16(v[6], v[7]);
        *(v4u*)(TQ + (size_t)rho * UK + kc * 8) = w; }
    for (int idx = tid_; idx < 128 * 32; idx += NTHR) { const int rr = idx >> 5, kc = idx & 31, sx = kc >> 1, cp0 = (kc & 1) * 8; float v[8];
#pragma unroll
        for (int e = 0; e < 8; ++e) v[e] = 0.f;
        const int rho = (rr < 64) ? 64 * hv + rr : 128 + 64 * hv + (rr - 64);
        if (rr < 64) { const int n = rho >> 1; const f32x2 P = pw[(15 - sx) * 64 + n];
#pragma unroll
            for (int e = 0; e < 8; ++e) { const f32x2 B = bb[n * 16 + cp0 + e]; v[e] = (rho & 1) ? (P.x * B.y + P.y * B.x) : (P.x * B.x - P.y * B.y); } }
        v4u w; w.x = cvt_pk_bf16(v[0], v[1]); w.y = cvt_pk_bf16(v[2], v[3]); w.z = cvt_pk_bf16(v[4], v[5]); w.w = cvt_pk_bf16(v[6], v[7]);
        *(v4u*)(PP + (size_t)rho * 256 + kc * 8) = w; }
    __syncthreads();
}

__device__ __forceinline__ void p0_prologue(const Args& a, const Ctx& F) {
    PHASE_IDS
    if (PROBE_SPIN == 21 && blockIdx.x == 0 && threadIdx.x == 0) ((unsigned long long*)((unsigned*)(a.ws + WS_CTL) + 3000))[21] = wall_clock64();
    for (int j = F.vcu; j < 2 * NG; j += F.G) s5_tables(a, F, j & (NG - 1), j >> 7);
    if (PROBE_SPIN == 21 && blockIdx.x == 0 && threadIdx.x == 0) ((unsigned long long*)((unsigned*)(a.ws + WS_CTL) + 3000))[22] = wall_clock64();
    LAS float* scr = (LAS float*)(F.lds + F.wave * 16384);
    const int gw = F.vcu * NWAVES + F.wave, NGW = F.G * NWAVES;
    colmax_matrix(a.in[I_WG1], D, FF, nullptr, (unsigned*)(a.ws + WS_CTL) + CW_CM, gw, NGW, lane_);
    colmax_matrix(a.in[I_WU1], D, FF, nullptr, (unsigned*)(a.ws + WS_CTL) + CW_CM + FF, gw, NGW, lane_);
    cvt_matrix<0>(a.in[I_WD1], FF, D, (bf16*)(a.ws + WS_W1D), scr, gw, NGW, lane_, nullptr, 0.5f);
    cvt_matrix<0>(a.in[I_WIN], D, 6144, (bf16*)(a.ws + WS_WIN), scr, gw, NGW, lane_, a.in[I_NMIX], 1.0f);
    cvt_matrix<0>(a.in[I_GLUW], DS, DS, (bf16*)(a.ws + WS_WGLU), scr, gw, NGW, lane_);
    cvt_matrix<3>(a.in[I_WOUT], D, D, (bf16*)(a.ws + WS_WOUT), scr, gw, NGW, lane_);
    for (int it = gw; it < 512; it += NGW) { const int h = it >> 6, which = (it >> 5) & 1, kb = (it >> 3) & 3, nb = it & 7, n0 = nb * 32;
        cvt_item(a.in[which ? I_WX : I_WA] + (size_t)h * 65536, 256, (bf16*)(a.ws + WS_WRG), 256, kb * 64, n0, (h * 2 + (n0 >> 7)) * 256 + which * 128 + (n0 & 127), scr, lane_); }
    for (int i = F.vcu * NTHR + tid_; i < DR; i += F.G * NTHR) ((float*)(a.ws + WS_C8))[i] = -8.0f * log1pf(expf(-a.in[I_LAM][i]));
    unsigned char* A1 = (unsigned char*)(a.ws + WS_AX); float* SA1 = (float*)(a.ws + WS_SW + 131072); float* H0M = (float*)(a.ws + WS_H0M); const float* g1 = a.in[I_N1];
    for (int m = gw; m < MP; m += NGW) {
        f32x4 v[16];
        if (m < MX + 16) { const float* src = (m < MX) ? a.in[I_X] + (size_t)m * D : a.in[I_META] + (size_t)(m - MX) * D;
#pragma unroll
            for (int j = 0; j < 16; ++j) v[j] = *(const f32x4*)(src + 4 * lane_ + 256 * j); }
        else {
#pragma unroll
            for (int j = 0; j < 16; ++j) v[j] = (f32x4){0.f, 0.f, 0.f, 0.f}; }
        if (m >= MX) {
#pragma unroll
            for (int j = 0; j < 16; ++j) *(f32x4*)(H0M + (size_t)(m - MX) * D + 4 * lane_ + 256 * j) = v[j]; }
        float s = 0.f;
#pragma unroll
        for (int j = 0; j < 16; ++j) s += (v[j][0] * v[j][0] + v[j][1] * v[j][1]) + (v[j][2] * v[j][2] + v[j][3] * v[j][3]);
        const float rs = __builtin_amdgcn_rsqf(wave_sum(s) * (1.0f / D) + EPS);
        float mx = 0.f;
#pragma unroll
        for (int j = 0; j < 16; ++j) { v[j] = v[j] * rs * *(const f32x4*)(g1 + 4 * lane_ + 256 * j);
            mx = fmaxf(fmaxf(mx, fmaxf(fabsf(v[j][0]), fabsf(v[j][1]))), fmaxf(fabsf(v[j][2]), fabsf(v[j][3]))); }
#pragma unroll
        for (int o = 1; o < 64; o <<= 1) mx = fmaxf(mx, __shfl_xor(mx, o));
        const float inv = mx > 0.f ? 127.0f / mx : 0.f;
        if (lane_ == 0) SA1[m] = mx * (1.0f / 127.0f);
#pragma unroll
        for (int j = 0; j < 16; ++j) *(unsigned*)(A1 + (size_t)m * D + 4 * lane_ + 256 * j) = pack_i8x4(v[j][0] * inv, v[j][1] * inv, v[j][2] * inv, v[j][3] * inv);
    }
}

__device__ __forceinline__ void p8_quant_w2(const Args& a, const Ctx& F) {
    PHASE_IDS
    LAS unsigned* scr = (LAS unsigned*)(F.lds + F.wave * 8192);
    const int gw = F.vcu * NWAVES + F.wave, NGW = F.G * NWAVES; const unsigned* cm = (const unsigned*)(a.ws + WS_CTL) + CW_CM + 2 * FF;
    quant_gu_matrix(a.in[I_WG2], D, FF, a.in[I_N2], cm, (unsigned char*)(a.ws + WS_W1GU), (float*)(a.ws + WS_SW), 0, scr, gw, NGW, lane_);
    quant_gu_matrix(a.in[I_WU2], D, FF, a.in[I_N2], cm + FF, (unsigned char*)(a.ws + WS_W1GU), (float*)(a.ws + WS_SW), 1, scr, gw, NGW, lane_);
}
__device__ __forceinline__ void p11_quant_wd(const Args& a, const Ctx& F, int wi, int nw) {
    PHASE_IDS
    LAS unsigned* scr = (LAS unsigned*)(F.lds + F.wave * 8192);
    quant_gu_matrix(a.in[I_WD2], FF, D, nullptr, (const unsigned*)(a.ws + WS_CTL) + CW_CMD, (unsigned char*)(a.ws + WS_W1D), (float*)(a.ws + WS_SW + 262144), -1, scr, wi * NWAVES + F.wave, nw * NWAVES, lane_, 0.5f);
}
__device__ __forceinline__ void p10_quant_h2(const Args& a, const Ctx& F) {
    PHASE_IDS
    const bf16* HB = (const bf16*)(a.ws + WS_HB); unsigned char* A2 = (unsigned char*)(a.ws + WS_AX); float* SA2 = (float*)(a.ws + WS_SW + 131072);
    const u64* ss2 = (const u64*)((const unsigned*)(a.ws + WS_CTL) + CW_SS) + MP;
    const int gw = F.vcu * NWAVES + F.wave, NGW = F.G * NWAVES;
    for (int m = gw; m < MX; m += NGW) { v4u w[8]; float mx = 0.f;
#pragma unroll
        for (int j = 0; j < 8; ++j) w[j] = *(const v4u*)(HB + (size_t)m * D + 8 * lane_ + 512 * j);
#pragma unroll
        for (int j = 0; j < 8; ++j) { mx = fmaxf(fmaxf(mx, fmaxf(fabsf(bf_lo(w[j].x)), fabsf(bf_hi(w[j].x)))), fmaxf(fabsf(bf_lo(w[j].y)), fabsf(bf_hi(w[j].y))));
                                      mx = fmaxf(fmaxf(mx, fmaxf(fabsf(bf_lo(w[j].z)), fabsf(bf_hi(w[j].z)))), fmaxf(fabsf(bf_lo(w[j].w)), fabsf(bf_hi(w[j].w)))); }
#pragma unroll
        for (int o = 1; o < 64; o <<= 1) mx = fmaxf(mx, __shfl_xor(mx, o));
        const float inv = mx > 0.f ? 127.0f / mx : 0.f;
        if (lane_ == 0) SA2[m] = mx * (1.0f / 127.0f) * __builtin_amdgcn_rsqf(ss_get(ss2 + m) * (1.0f / D) + EPS);
#pragma unroll
        for (int j = 0; j < 8; ++j) { v2u q; q.x = pack_i8x4(bf_lo(w[j].x) * inv, bf_hi(w[j].x) * inv, bf_lo(w[j].y) * inv, bf_hi(w[j].y) * inv);
            q.y = pack_i8x4(bf_lo(w[j].z) * inv, bf_hi(w[j].z) * inv, bf_lo(w[j].w) * inv, bf_hi(w[j].w) * inv); *(v2u*)(A2 + (size_t)m * D + 8 * lane_ + 512 * j) = q; } }
}

__device__ __forceinline__ void p12_quant_h(const Args& a, const Ctx& F) {
    PHASE_IDS
    const bf16* H = (const bf16*)(a.ws + WS_H); unsigned char* Hq = (unsigned char*)(a.ws + WS_AX); float* SH = (float*)(a.ws + WS_SW + 393216);
    LAS float* xm = (LAS float*)F.lds;
    const int pair = F.wave >> 1, hf = F.wave & 1, NP = F.G * 4;
    int it = 0;
    for (int m = F.vcu * 4 + pair; m < MX; m += NP, ++it) {
        v4u w[11]; float mx = 0.f;
#pragma unroll
        for (int j = 0; j < 11; ++j) { const int ch = lane_ + 64 * (j + 11 * hf); w[j] = (ch < FF / 8) ? *(const v4u*)(H + (size_t)m * FF + 8 * ch) : (v4u){0u, 0u, 0u, 0u}; }
#pragma unroll
        for (int j = 0; j < 11; ++j) { mx = fmaxf(fmaxf(mx, fmaxf(fabsf(bf_lo(w[j].x)), fabsf(bf_hi(w[j].x)))), fmaxf(fabsf(bf_lo(w[j].y)), fabsf(bf_hi(w[j].y))));
                                       mx = fmaxf(fmaxf(mx, fmaxf(fabsf(bf_lo(w[j].z)), fabsf(bf_hi(w[j].z)))), fmaxf(fabsf(bf_lo(w[j].w)), fabsf(bf_hi(w[j].w)))); }
#pragma unroll
        for (int o = 1; o < 64; o <<= 1) mx = fmaxf(mx, __shfl_xor(mx, o));
        if (lane_ == 0) xm[(it & 1) * 8 + F.wave] = mx;
        __syncthreads();
        mx = fmaxf(mx, xm[(it & 1) * 8 + (F.wave ^ 1)]);
        const float inv = mx > 0.f ? 127.0f / mx : 0.f;
        if (lane_ == 0 && hf == 0) SH[m] = mx * (1.0f / 127.0f);
#pragma unroll
        for (int j = 0; j < 11; ++j) { const int ch = lane_ + 64 * (j + 11 * hf);
            if (ch < FF / 8) { v2u q; q.x = pack_i8x4(bf_lo(w[j].x) * inv, bf_hi(w[j].x) * inv, bf_lo(w[j].y) * inv, bf_hi(w[j].y) * inv);
                q.y = pack_i8x4(bf_lo(w[j].z) * inv, bf_hi(w[j].z) * inv, bf_lo(w[j].w) * inv, bf_hi(w[j].w) * inv); *(v2u*)(Hq + (size_t)m * FF + 8 * ch) = q; } } }
    __syncthreads();
}

__device__ __forceinline__ void p1_quant_w1(const Args& a, const Ctx& F) {
    PHASE_IDS
    LAS unsigned* scr = (LAS unsigned*)(F.lds + F.wave * 8192);
    const int gw = F.vcu * NWAVES + F.wave, NGW = F.G * NWAVES; const unsigned* cm = (const unsigned*)(a.ws + WS_CTL) + CW_CM;
    quant_gu_matrix(a.in[I_WG1], D, FF, nullptr, cm, (unsigned char*)(a.ws + WS_W1GU), (float*)(a.ws + WS_SW), 0, scr, gw, NGW, lane_);
    quant_gu_matrix(a.in[I_WU1], D, FF, nullptr, cm + FF, (unsigned char*)(a.ws + WS_W1GU), (float*)(a.ws + WS_SW), 1, scr, gw, NGW, lane_);
}

__device__ __forceinline__ void p4_conv(const Args& a, const Ctx& F) {
    PHASE_IDS
    const bf16* ur = (const bf16*)((const char*)a.out + DO_URG); bf16* xcb = (bf16*)(a.ws + WS_XCB);
    const float* cw = a.in[I_CONVW]; const float* cb = a.in[I_CONVB];
    for (int idx = F.vcu * NTHR + tid_; idx < (MP / 8) * 512; idx += F.G * NTHR) { const int row0 = (idx >> 9) * 8, c4 = (idx & 511) * 4;
        const f32x4 bias = *(const f32x4*)(cb + c4), w0 = *(const f32x4*)(cw + c4), w1 = *(const f32x4*)(cw + DR + c4), w2 = *(const f32x4*)(cw + 2 * DR + c4), w3 = *(const f32x4*)(cw + 3 * DR + c4);
        f32x4 uu[11];
#pragma unroll
        for (int j = 0; j < 11; ++j) { const int r = row0 - 3 + j; int srow;
            if (row0 < MX) srow = (j >= 3) ? r : (((row0 & 4095) != 0) ? r : MX + 13 + j);
            else srow = (j >= 3 || row0 > MX) ? r : -1;
            if (srow >= 0) { const v2u w = *(const v2u*)(ur + (size_t)srow * DR + c4); uu[j] = (f32x4){bf_lo(w.x), bf_hi(w.x), bf_lo(w.y), bf_hi(w.y)}; } else uu[j] = (f32x4){0.f, 0.f, 0.f, 0.f}; }
#pragma unroll
        for (int j = 0; j < 8; ++j) { const f32x4 sv = bias + w0 * uu[j] + w1 * uu[j + 1] + w2 * uu[j + 2] + w3 * uu[j + 3];
            v2u w; w.x = cvt_pk_bf16(sv[0], sv[1]); w.y = cvt_pk_bf16(sv[2], sv[3]); *(v2u*)(xcb + (size_t)(row0 + j) * DR + c4) = w; } }
    LAS float* scr = (LAS float*)(F.lds + F.wave * 16384);
    const int gw = F.vcu * NWAVES + F.wave, NGW = F.G * NWAVES;
    colmax_matrix(a.in[I_WG2], D, FF, a.in[I_N2], (unsigned*)(a.ws + WS_CTL) + CW_CM + 2 * FF, gw, NGW, lane_);
    colmax_matrix(a.in[I_WU2], D, FF, a.in[I_N2], (unsigned*)(a.ws + WS_CTL) + CW_CM + 3 * FF, gw, NGW, lane_);
    colmax_matrix(a.in[I_WD2], FF, D, nullptr, (unsigned*)(a.ws + WS_CTL) + CW_CMD, gw, NGW, lane_);
}

__device__ __forceinline__ void p6_scans(const Args& a, const Ctx& F) {
    PHASE_IDS
    unsigned* LA = (unsigned*)(a.out + DO_UA / 4); unsigned* BX = (unsigned*)(a.ws + WS_AX);
    float* segP = (float*)(a.ws + WS_SEG); float* segH = segP + 4 * NSEG * DR;
    for (int w = F.vcu; w < 256; w += F.G) { const int b = w >> 6, seg = (w >> 1) & 31, cp = (w & 1) * 512 + tid_;
        const size_t base = ((size_t)b * 4096 + seg * SEGL) * (DR / 2) + cp;
        float h0 = 0.f, h1 = 0.f, P0 = 1.f, P1 = 1.f;
        for (int t0 = 0; t0 < SEGL; t0 += 16) { unsigned lv[16], xv[16];
#pragma unroll
            for (int j = 0; j < 16; ++j) { lv[j] = LA[base + (size_t)(t0 + j) * (DR / 2)]; xv[j] = BX[base + (size_t)(t0 + j) * (DR / 2)]; }
#pragma unroll
            for (int j = 0; j < 16; ++j) { const float a0 = __builtin_amdgcn_exp2f(1.4426950408889634f * bf_lo(lv[j])), a1 = __builtin_amdgcn_exp2f(1.4426950408889634f * bf_hi(lv[j]));
                h0 = a0 * h0 + bf_lo(xv[j]); h1 = a1 * h1 + bf_hi(xv[j]); P0 *= a0; P1 *= a1;
                BX[base + (size_t)(t0 + j) * (DR / 2)] = cvt_pk_bf16(h0, h1); LA[base + (size_t)(t0 + j) * (DR / 2)] = cvt_pk_bf16(P0, P1); } }
        *(f32x2*)(segP + (size_t)(b * NSEG + seg) * DR + 2 * cp) = (f32x2){P0, P1}; *(f32x2*)(segH + (size_t)(b * NSEG + seg) * DR + 2 * cp) = (f32x2){h0, h1}; }
}

__device__ __forceinline__ void s5_carry_unit(const Args& a, int b, int g, int n) {
    bf16* U = (bf16*)(a.ws + WS_U); const float* E = a.out + DO_E / 4; const float* BBg = (const float*)(a.ws + WS_S5BB); const float* LAMg = (const float*)(a.ws + WS_S5LAM);
    const f32x4 lm = *(const f32x4*)(LAMg + (size_t)(g * 64 + n) * 4);
    f32x4 bq[8];
#pragma unroll
    for (int j = 0; j < 8; ++j) bq[j] = *(const f32x4*)(BBg + (size_t)(g * 64 + n) * 32 + 4 * j);
    float sr = 0.f, si = 0.f;
    const bf16* um = U + ((size_t)g * NCHP + NCHX) * UK;
    for (int s0 = 0; s0 < 16; s0 += 4) { v4u w0[4], w1[4];
#pragma unroll
        for (int q = 0; q < 4; ++q) { w0[q] = *(const v4u*)(um + (s0 + q) * 16); w1[q] = *(const v4u*)(um + (s0 + q) * 16 + 8); }
#pragma unroll
        for (int q = 0; q < 4; ++q) {
            const float uu[16] = {bf_lo(w0[q].x), bf_hi(w0[q].x), bf_lo(w0[q].y), bf_hi(w0[q].y), bf_lo(w0[q].z), bf_hi(w0[q].z), bf_lo(w0[q].w), bf_hi(w0[q].w),
                                  bf_lo(w1[q].x), bf_hi(w1[q].x), bf_lo(w1[q].y), bf_hi(w1[q].y), bf_lo(w1[q].z), bf_hi(w1[q].z), bf_lo(w1[q].w), bf_hi(w1[q].w)};
            float br = 0.f, bi = 0.f;
#pragma unroll
            for (int j = 0; j < 8; ++j) { br += bq[j][0] * uu[2 * j] + bq[j][2] * uu[2 * j + 1]; bi += bq[j][1] * uu[2 * j] + bq[j][3] * uu[2 * j + 1]; }
            const float nr = lm[0] * sr - lm[1] * si + br, ni = lm[0] * si + lm[1] * sr + bi; sr = nr; si = ni; } }
    bf16* up = U + ((size_t)g * NCHP + b * 256) * UK + 256 + 2 * n; const float* ep = E + ((size_t)g * NCHX + b * 256) * 128 + 2 * n;
    for (int k0 = 0; k0 < 256; k0 += 16) { f32x2 ev[16];
#pragma unroll
        for (int j = 0; j < 16; ++j) ev[j] = *(const f32x2*)(ep + (size_t)(k0 + j) * 128);
#pragma unroll
        for (int j = 0; j < 16; ++j) { *(unsigned*)(up + (size_t)(k0 + j) * UK) = cvt_pk_bf16(sr, si);
            const float nr = lm[2] * sr - lm[3] * si + ev[j].x, ni = lm[2] * si + lm[3] * sr + ev[j].y; sr = nr; si = ni; } }
}

__device__ __forceinline__ void p7_rgfix(const Args& a, const Ctx& F) {
    PHASE_IDS
    const bf16* PA = (const bf16*)(a.out + DO_UA / 4); const bf16* HL = (const bf16*)(a.ws + WS_AX); const bf16* GG = (const bf16*)(a.ws + WS_GG);
    const float* segP = (const float*)(a.ws + WS_SEG); const float* segH = segP + 4 * NSEG * DR; const float* gn = a.in[I_NRG];
    bf16* AO = (bf16*)(a.ws + WS_AX2);
    LAS f32x4* carry = (LAS f32x4*)(F.lds);
    for (int w = F.vcu; w < 256; w += F.G) { const int b = w >> 6, seg = (w >> 1) & 31, q = w & 1;
        { const int c4 = tid_ * 4; f32x4 h = {0.f, 0.f, 0.f, 0.f};
            for (int r0 = 0; r0 < 16; r0 += 8) { v2u pa[8], pb[8];
#pragma unroll
                for (int j = 0; j < 8; ++j) { pa[j] = *(const v2u*)(PA + (size_t)(MX + r0 + j) * DR + c4); pb[j] = *(const v2u*)(HL + (size_t)(MX + r0 + j) * DR + c4); }
#pragma unroll
                for (int j = 0; j < 8; ++j) { const f32x4 la = {bf_lo(pa[j].x), bf_hi(pa[j].x), bf_lo(pa[j].y), bf_hi(pa[j].y)}, bx = {bf_lo(pb[j].x), bf_hi(pb[j].x), bf_lo(pb[j].y), bf_hi(pb[j].y)};
                    f32x4 av;
#pragma unroll
                    for (int e = 0; e < 4; ++e) av[e] = __builtin_amdgcn_exp2f(1.4426950408889634f * la[e]);
                    h = av * h + bx; } }
            for (int s0 = 0; s0 < seg; s0 += 8) { f32x4 pa[8], pb[8];
#pragma unroll
                for (int j = 0; j < 8; ++j) { const bool ok = s0 + j < seg; const size_t o = (size_t)(b * NSEG + (ok ? s0 + j : 0)) * DR + c4;
                    pa[j] = *(const f32x4*)(segP + o); pb[j] = *(const f32x4*)(segH + o); if (!ok) { pa[j] = (f32x4){1.f, 1.f, 1.f, 1.f}; pb[j] = (f32x4){0.f, 0.f, 0.f, 0.f}; } }
#pragma unroll
                for (int j = 0; j < 8; ++j) h = pa[j] * h + pb[j]; }
            carry[tid_] = h; }
        __syncthreads();
        for (int rr = 0; rr < 8; ++rr) { const int row = b * 4096 + seg * SEGL + q * 64 + F.wave * 8 + rr;
            float y[4][8]; float s = 0.f;
#pragma unroll
            for (int j = 0; j < 4; ++j) { const int c = 8 * lane_ + 512 * j; const size_t off = (size_t)row * DR + c;
                const v4u hw = *(const v4u*)(HL + off), pw = *(const v4u*)(PA + off), gw = *(const v4u*)(GG + off); const f32x4 c0 = carry[2 * lane_ + 128 * j], c1 = carry[2 * lane_ + 128 * j + 1];
                const float hh[8] = {bf_lo(hw.x), bf_hi(hw.x), bf_lo(hw.y), bf_hi(hw.y), bf_lo(hw.z), bf_hi(hw.z), bf_lo(hw.w), bf_hi(hw.w)};
                const float pp[8] = {bf_lo(pw.x), bf_hi(pw.x), bf_lo(pw.y), bf_hi(pw.y), bf_lo(pw.z), bf_hi(pw.z), bf_lo(pw.w), bf_hi(pw.w)};
                const float gv[8] = {bf_lo(gw.x), bf_hi(gw.x), bf_lo(gw.y), bf_hi(gw.y), bf_lo(gw.z), bf_hi(gw.z), bf_lo(gw.w), bf_hi(gw.w)};
                const float cr[8] = {c0[0], c0[1], c0[2], c0[3], c1[0], c1[1], c1[2], c1[3]};
#pragma unroll
                for (int e = 0; e < 8; ++e) { y[j][e] = (hh[e] + pp[e] * cr[e]) * gv[e]; s += y[j][e] * y[j][e]; } }
            const float rs = __builtin_amdgcn_rsqf(wave_sum(s) * (1.0f / DR) + EPS);
#pragma unroll
            for (int j = 0; j < 4; ++j) { const int c = 8 * lane_ + 512 * j; const f32x4 g0 = *(const f32x4*)(gn + c), g1 = *(const f32x4*)(gn + c + 4);
                v4u wv; wv.x = cvt_pk_bf16(y[j][0] * rs * g0[0], y[j][1] * rs * g0[1]); wv.y = cvt_pk_bf16(y[j][2] * rs * g0[2], y[j][3] * rs * g0[3]);
                wv.z = cvt_pk_bf16(y[j][4] * rs * g1[0], y[j][5] * rs * g1[1]); wv.w = cvt_pk_bf16(y[j][6] * rs * g1[2], y[j][7] * rs * g1[3]);
                *(v4u*)(AO + (size_t)row * D + DR + c) = wv; } }
        __syncthreads(); }
}

__device__ __forceinline__ void p9_s5norm(const Args& a, const Ctx& F) {
    PHASE_IDS
    const float* yg = (const float*)(a.ws + WS_AX); const u64* ss = (const u64*)((const unsigned*)(a.ws + WS_CTL) + CW_SS) + 3 * MP; bf16* AO = (bf16*)(a.ws + WS_AX2);
    const int gw = F.vcu * NWAVES + F.wave, NGW = F.G * NWAVES;
    for (int m = gw; m < MX; m += NGW) { const float rs = __builtin_amdgcn_rsqf(ss_get(ss + m) * (1.0f / DS) + EPS);
#pragma unroll
        for (int j = 0; j < 8; ++j) { const int c = 4 * lane_ + 256 * j; const f32x4 o = *(const f32x4*)(yg + (size_t)m * DS + c) * rs;
            v2u wv; wv.x = cvt_pk_bf16(o[0], o[1]); wv.y = cvt_pk_bf16(o[2], o[3]); *(v2u*)(AO + (size_t)m * D + DR + c) = wv; } }
}

__device__ __forceinline__ void p13_final(const Args& a, const Ctx& F) {
    PHASE_IDS
    const u64* ss = (const u64*)((const unsigned*)(a.ws + WS_CTL) + CW_SS) + 2 * MP; const bf16* T = (const bf16*)(a.ws + WS_H);
    const int gw = F.vcu * NWAVES + F.wave, NGW = F.G * NWAVES;
    for (int m = gw; m < MX; m += NGW) { const float rs = __builtin_amdgcn_rsqf(ss_get(ss + m) * (1.0f / D) + EPS);
        v4u w[8];
#pragma unroll
        for (int j = 0; j < 8; ++j) w[j] = *(const v4u*)(T + (size_t)m * D + 8 * lane_ + 512 * j);
#pragma unroll
        for (int j = 0; j < 8; ++j) { float* p = a.out + (size_t)m * D + 8 * lane_ + 512 * j;
            *(f32x4*)p = (f32x4){bf_lo(w[j].x) * rs, bf_hi(w[j].x) * rs, bf_lo(w[j].y) * rs, bf_hi(w[j].y) * rs}; *(f32x4*)(p + 4) = (f32x4){bf_lo(w[j].z) * rs, bf_hi(w[j].z) * rs, bf_lo(w[j].w) * rs, bf_hi(w[j].w) * rs}; } }
}

__device__ __forceinline__ f32x4 skinny_tile(const bf16* A, int lda, const bf16* Bt, int ldb, int ksteps, int wave, int lane, LAS float* red) {
    typedef short bf16x8 __attribute__((ext_vector_type(8)));
    const int fr = lane & 15, fq = lane >> 4;
    const bf16* ap = A + (size_t)fr * lda + (size_t)wave * ksteps * 32 + 8 * fq;
    const bf16* bp = Bt + (size_t)fr * ldb + (size_t)wave * ksteps * 32 + 8 * fq;
    f32x4 acc = {0.f, 0.f, 0.f, 0.f};
    int s0 = 0;
    for (; s0 + 8 <= ksteps; s0 += 8) { bf16x8 av[8], bv[8];
#pragma unroll
        for (int j = 0; j < 8; ++j) { av[j] = *(const bf16x8*)(ap + 32 * (s0 + j)); bv[j] = *(const bf16x8*)(bp + 32 * (s0 + j)); }
#pragma unroll
        for (int j = 0; j < 8; ++j) acc = __builtin_amdgcn_mfma_f32_16x16x32_bf16(bv[j], av[j], acc, 0, 0, 0); }
    for (; s0 < ksteps; ++s0) { const bf16x8 av = *(const bf16x8*)(ap + 32 * s0), bv = *(const bf16x8*)(bp + 32 * s0); acc = __builtin_amdgcn_mfma_f32_16x16x32_bf16(bv, av, acc, 0, 0, 0); }
    *(LAS f32x4*)(red + (wave * 64 + lane) * 4) = acc;
    __syncthreads();
    f32x4 r = {0.f, 0.f, 0.f, 0.f};
    if (wave == 0) {
#pragma unroll
        for (int w = 0; w < 8; ++w) r += *(const LAS f32x4*)(red + (w * 64 + lane) * 4); }
    __syncthreads();
    return r;
}
__device__ __forceinline__ void skinny_g2_meta(const Args& a, const Ctx& F) {
    PHASE_IDS
    const bf16* Hm = (const bf16*)(a.ws + WS_H) + (size_t)MX * FF; const bf16* Wd = (const bf16*)(a.ws + WS_W1D);
    const float* h0 = (const float*)(a.ws + WS_H0M); bf16* HB = (bf16*)(a.ws + WS_HB); u64* ss = (u64*)((unsigned*)(a.ws + WS_CTL) + CW_SS);
    for (int nb = F.vcu; nb < D / 16; nb += F.G) { const int n0 = nb * 16;
        const f32x4 c = skinny_tile(Hm, FF, Wd + (size_t)n0 * FF, FF, FF / 32 / 8, F.wave, lane_, (LAS float*)F.lds);
        if (F.wave == 0) { const int fr = lane_ & 15, col = n0 + 4 * (lane_ >> 4);
            const f32x4 v = *(const f32x4*)(h0 + (size_t)fr * D + col) + c;
            v2u o; o.x = cvt_pk_bf16(v[0], v[1]); o.y = cvt_pk_bf16(v[2], v[3]); *(v2u*)(HB + (size_t)(MX + fr) * D + col) = o;
            float q = (v[0] * v[0] + v[1] * v[1]) + (v[2] * v[2] + v[3] * v[3]); q += __shfl_xor(q, 16); q += __shfl_xor(q, 32);
            if (lane_ < 16) ss_add(ss + MX + fr, q); } }
}
__device__ __forceinline__ void skinny_win_meta(const Args& a, const Ctx& F) {
    PHASE_IDS
    const bf16* Am = (const bf16*)(a.ws + WS_HB) + (size_t)MX * D; const bf16* Wi = (const bf16*)(a.ws + WS_WIN);
    const u64* ss = (const u64*)((const unsigned*)(a.ws + WS_CTL) + CW_SS); bf16* urg = (bf16*)((char*)a.out + DO_URG); bf16* U = (bf16*)(a.ws + WS_U);
    for (int nb = F.vcu; nb < 256; nb += F.G) { const int n0 = (nb < 128) ? nb * 16 : 4096 + (nb - 128) * 16;
        const f32x4 c = skinny_tile(Am, D, Wi + (size_t)n0 * D, D, D / 32 / 8, F.wave, lane_, (LAS float*)F.lds);
        if (F.wave == 0) { const int fr = lane_ & 15, c4 = 4 * (lane_ >> 4);
            const f32x4 v = c * __builtin_amdgcn_rsqf(ss_get(ss + MX + fr) * (1.0f / D) + EPS);
            v2u o; o.x = cvt_pk_bf16(v[0], v[1]); o.y = cvt_pk_bf16(v[2], v[3]);
            if (nb < 128) *(v2u*)(urg + (size_t)(MX + fr) * DR + n0 + c4) = o;
            else *(v2u*)(U + ((size_t)(nb - 128) * NCHP + NCHX) * UK + fr * 16 + c4) = o; } }
}


__device__ __forceinline__ void skinny_gates_meta(const Args& a, const Ctx& F) {
    PHASE_IDS
    const bf16* xcb = (const bf16*)(a.ws + WS_XCB) + (size_t)MX * DR; const bf16* Wrg = (const bf16*)(a.ws + WS_WRG); const float* c8t = (const float*)(a.ws + WS_C8);
    bf16* LA = (bf16*)(a.out + DO_UA / 4); bf16* BX = (bf16*)(a.ws + WS_AX);
    for (int nb = F.vcu; nb < DR / 16; nb += F.G) { const int ch0 = nb * 16, h = ch0 >> 8, hf = (ch0 >> 7) & 1, j0 = ch0 & 127;
        const bf16* Wa = Wrg + (size_t)((h * 2 + hf) * 256 + j0) * 256;
        const f32x4 ta = skinny_tile(xcb + h * 256, DR, Wa, 256, 1, F.wave, lane_, (LAS float*)F.lds);
        const f32x4 tx = skinny_tile(xcb + h * 256, DR, Wa + 128 * 256, 256, 1, F.wave, lane_, (LAS float*)F.lds);
        if (F.wave == 0) { const int fr = lane_ & 15, c = ch0 + 4 * (lane_ >> 4);
            const f32x4 ba = *(const f32x4*)(a.in[I_BA] + c), bx = *(const f32x4*)(a.in[I_BX] + c), c8 = *(const f32x4*)(c8t + c);
            const v2u xw = *(const v2u*)(xcb + (size_t)fr * DR + c); const f32x4 xv = {bf_lo(xw.x), bf_hi(xw.x), bf_lo(xw.y), bf_hi(xw.y)};
            f32x4 l;
#pragma unroll
            for (int e = 0; e < 4; ++e) l[e] = c8[e] * fsigmoid(ta[e] + ba[e]);
            v2u lw; lw.x = cvt_pk_bf16(l[0], l[1]); lw.y = cvt_pk_bf16(l[2], l[3]);
            const f32x4 r = {bf_lo(lw.x), bf_hi(lw.x), bf_lo(lw.y), bf_hi(lw.y)}; f32x4 o;
#pragma unroll
            for (int e = 0; e < 4; ++e) o[e] = __builtin_amdgcn_sqrtf(one_minus_exp(2.0f * r[e])) * fsigmoid(tx[e] + bx[e]) * xv[e];
            v2u ow; ow.x = cvt_pk_bf16(o[0], o[1]); ow.y = cvt_pk_bf16(o[2], o[3]);
            *(v2u*)(LA + (size_t)(MX + fr) * DR + c) = lw; *(v2u*)(BX + (size_t)(MX + fr) * DR + c) = ow; } }
}

__global__ void __launch_bounds__(NTHR, 2) hymba_fwd(Args a) {
    extern __shared__ __attribute__((aligned(16))) unsigned char lds_raw[];
    Ctx F; F.lds = (LAS unsigned char*)lds_raw; F.wave = __builtin_amdgcn_readfirstlane((int)threadIdx.x >> 6);
    F.G = gridDim.x; { const int bx = blockIdx.x; F.vcu = (F.G % 8 == 0) ? (bx % 8) * (F.G / 8) + bx / 8 : bx; }
    volatile LAS unsigned* MISC = (volatile LAS unsigned*)(F.lds + MISC_OFF);
    for (int u = threadIdx.x; u < (LDS_BYTES - RING_BYTES) / 4; u += NTHR) ((LAS unsigned*)(F.lds + RING_BYTES))[u] = 0u;
    __syncthreads();
    unsigned* ctl = (unsigned*)(a.ws + WS_CTL);
    XcdBarrier bar; bar.bar = ctl + CW_BAR; bar.x = 0; bar.st = nullptr;
    if (MK_N_LAUNCHES == 1) bar = xcd_barrier_post(ctl + CW_BAR, MISC + 8);
    const int lo = a.ph_lo, hi = a.ph_hi;
#define IN(k) (lo <= (k) && (k) < hi)
#define SEAM(k) do { if (IN(k) && IN((k) + 1)) xcd_barrier(bar); if (PROBE_SPIN >= 0 && blockIdx.x == 0 && threadIdx.x == 0) { ((unsigned long long*)(ctl + 3000))[(k) + 1] = wall_clock64(); ((unsigned long long*)(ctl + 3000))[100 + (k) + 1] = clock64(); } } while (0)
    u64* ssb = (u64*)(ctl + CW_SS);
    bf16* AX = (bf16*)(a.ws + WS_AX); bf16* HH = (bf16*)(a.ws + WS_H); bf16* HB = (bf16*)(a.ws + WS_HB);
    const int me = (int)blockIdx.x;

    if (PROBE_SPIN >= 0 && blockIdx.x == 0 && threadIdx.x == 0) ((unsigned long long*)(ctl + 3000))[0] = wall_clock64();
    if (IN(0)) { p0_prologue(a, F); if (PROBE_DUP == 0) { __syncthreads(); p0_prologue(a, F); } } SEAM(0);
    if (IN(1)) { p1_quant_w1(a, F); } SEAM(1);
    if (IN(2)) {
        pg8::Gemm g{(const bf16*)(a.ws + WS_AX), (const bf16*)(a.ws + WS_W1GU), D / 2, D / 2, D / 2, 0, 0u}; pg8::StaticOrder S; S.init(NPP, 2 * FF / 256, F.G, me, 16, 16);
        EpiSwigluI8<false> E{HH, (const float*)(a.ws + WS_SW + 131072), nullptr, (const float*)(a.ws + WS_SW), nullptr};
        pg8::gemm_phase<EpiSwigluI8<false>, true, true, false, (PROBE_SPIN >= 30 && PROBE_GP == 2), true>(F.lds, F.wave, g, S, E, nullptr, 0.f, 0.f, (unsigned long long*)(ctl + 3000) + 30); } SEAM(2);
    if (IN(3)) {
        skinny_g2_meta(a, F);
        pg8::Gemm g{HH, (const bf16*)(a.ws + WS_W1D), FF, FF, FF, 0, 0u}; pg8::StaticOrder S; S.init(NPX, D / 256, F.G, me, 16, 16);
        EpiResidB<true, false> E{a.in[I_X], HB, nullptr, ssb};
        pg8::gemm_phase<EpiResidB<true, false>, true, true>(F.lds, F.wave, g, S, E); } SEAM(3);
    if (IN(4)) {
        skinny_win_meta(a, F);
        pg8::Gemm g{HB, (const bf16*)(a.ws + WS_WIN), D, D, D, 0, 0u}; pg8::StaticOrder S; S.init(NPX, 6144 / 256, F.G, me, 32, 8);
        EpiWin E{ssb, (bf16*)((char*)a.out + DO_URG), (bf16*)(a.ws + WS_GG), (bf16*)(a.ws + WS_U)};
        pg8::gemm_phase<EpiWin, true, true>(F.lds, F.wave, g, S, E);
        if (PROBE_DUP == 3) pg8::gemm_phase<EpiWin, true, true>(F.lds, F.wave, g, S, E); } SEAM(4);
    if (IN(5)) { p4_conv(a, F); if (PROBE_DUP == 4) { __syncthreads(); p4_conv(a, F); } } SEAM(5);
    if (IN(6)) {
        skinny_gates_meta(a, F);
        { pg8::Gemm g{(const bf16*)(a.ws + WS_XCB), (const bf16*)(a.ws + WS_WRG), DR, 256, 256, 1, 512u}; pg8::StaticOrder S; S.init(NPX, 16, F.G, me);
          EpiGates E{a.in[I_BA], a.in[I_BX], (const float*)(a.ws + WS_C8), (const bf16*)(a.ws + WS_XCB), (bf16*)(a.out + DO_UA / 4), (bf16*)(a.ws + WS_AX)};
          pg8::gemm_phase<EpiGates, true, true>(F.lds, F.wave, g, S, E); }
        { pg8::StaticOrder S; S.init(4, NG, F.G, me);
          { pg8::Gemm g{(const bf16*)(a.ws + WS_U), (const bf16*)(a.ws + WS_S5P), UK, 256, 256, 0, (unsigned)(NCHP * UK * 2)};
            EpiS5E E{a.out + DO_E / 4};
            pg8::gemm_phase<EpiS5E, true, true>(F.lds, F.wave, g, S, E); }
          { __builtin_amdgcn_fence(__ATOMIC_ACQUIRE, "agent");
            for (int i = F.wave; ; i += NWAVES) { pg8::Unit u; if (!S.next(i, u)) break; s5_carry_unit(a, u.pm, u.pn, pg8::lane_id_opaque()); }
            VM_WAIT(); __syncthreads(); __builtin_amdgcn_fence(__ATOMIC_ACQUIRE, "agent"); VM_WAIT(); __syncthreads(); }
          { pg8::Gemm g{(const bf16*)(a.ws + WS_U), (const bf16*)(a.ws + WS_S5TQ), UK, UK, UK, 0, (unsigned)(NCHP * UK * 2)};
            EpiS5Y E{(bf16*)(a.ws + WS_Z)};
            pg8::gemm_phase<EpiS5Y, true, true>(F.lds, F.wave, g, S, E); } } } SEAM(6);
    if (IN(7)) {
        p6_scans(a, F);
        pg8::Gemm g{(const bf16*)(a.ws + WS_Z), (const bf16*)(a.ws + WS_WGLU), DS, DS, DS, 0, 0u}; pg8::StaticOrder S; S.init(NPX, DS / 256, F.G, me, 32, 8);
        EpiGlu E{(const bf16*)(a.ws + WS_Z), a.in[I_GLUB], a.in[I_NS5], (bf16*)(a.ws + WS_AX2), ssb + 3 * MP};
        pg8::gemm_phase<EpiGlu, true, true>(F.lds, F.wave, g, S, E); } SEAM(7);
    if (IN(8)) { p7_rgfix(a, F); p8_quant_w2(a, F); } SEAM(8);
    if (IN(9)) {
        pg8::Gemm g{(const bf16*)(a.ws + WS_AX2), (const bf16*)(a.ws + WS_WOUT), D, D, D, 0, 0u}; pg8::StaticOrder S; S.init(NPX, D / 256, F.G, me, 16, 16);
        EpiResidB<false, false> E{HB, HB, nullptr, ssb + MP};
        pg8::gemm_phase<EpiResidB<false, false>, true, true, true, (PROBE_SPIN >= 30 && PROBE_GP == 9)>(F.lds, F.wave, g, S, E, ssb + 3 * MP, 1.0f / DS, EPS, (unsigned long long*)(ctl + 3000) + 30); } SEAM(9);
    if (IN(10)) { p10_quant_h2(a, F); } SEAM(10);
    if (IN(11)) {
        pg8::Gemm g{(const bf16*)(a.ws + WS_AX), (const bf16*)(a.ws + WS_W1GU), D / 2, D / 2, D / 2, 0, 0u}; pg8::StaticOrder S; S.init(NPX, 2 * FF / 256, F.G, me, 16, 16);
        EpiSwigluI8<false> E{HH, (const float*)(a.ws + WS_SW + 131072), nullptr, (const float*)(a.ws + WS_SW), nullptr};
        pg8::gemm_phase<EpiSwigluI8<false>, true, true, false, (PROBE_SPIN >= 30 && PROBE_GP == 11), true>(F.lds, F.wave, g, S, E, nullptr, 0.f, 0.f, (unsigned long long*)(ctl + 3000) + 30);
        { const int rem = (NPX * (2 * FF / 256)) % F.G;
          if (rem == 0) p11_quant_wd(a, F, F.vcu, F.G); else if (me >= rem) p11_quant_wd(a, F, me - rem, F.G - rem); } } SEAM(11);
    if (IN(12)) { p12_quant_h(a, F); } SEAM(12);
    if (IN(13)) {
        pg8::Gemm g{(const bf16*)(a.ws + WS_AX), (const bf16*)(a.ws + WS_W1D), FF / 2, FF / 2, FF / 2, 0, 0u}; pg8::StaticOrder S; S.init(NPX, D / 256, F.G, me, 16, 16);
        EpiResidI8 E{HB, HH, a.in[I_NFIN], ssb + 2 * MP, (const float*)(a.ws + WS_SW + 393216), (const float*)(a.ws + WS_SW + 262144)};
        pg8::gemm_phase<EpiResidI8, true, true, false, false, true>(F.lds, F.wave, g, S, E); } SEAM(13);
    if (IN(14)) { p13_final(a, F); }
    if (PROBE_SPIN >= 0 && blockIdx.x == PROBE_BLK && threadIdx.x == 0) { VM_WAIT(); const unsigned long long t1 = wall_clock64(); const unsigned long long* ts = (const unsigned long long*)(ctl + 3000);
        unsigned long long dt = (PROBE_SPIN >= 30) ? (ts[PROBE_B] - ts[PROBE_A]) : (((PROBE_SPIN == N_PHASES - 1) ? t1 : ts[PROBE_SPIN + 1]) - ts[PROBE_SPIN]);
        if (PROBE_SPIN >= 100) { const int p = PROBE_SPIN - 100; dt = (ts[100 + p + 1] - ts[100 + p]) * 10000ull / (ts[p + 1] - ts[p]); }
        const unsigned long long until = t1 + (unsigned long long)(PROBE_SPIN >= 100 ? 1 : (PROBE_SPIN >= 30 ? PROBE_MUL : 10)) * dt;
        while (wall_clock64() < until) __builtin_amdgcn_s_sleep(16); }
#undef IN
#undef SEAM
}

extern "C" void kernel_launch(void* const* d_in, const int* in_sizes, int n_in, void* d_out, int out_size, void* d_ws, size_t ws_size, hipStream_t stream) {
    static int grid = 0;
    if (grid == 0) {
        if (n_in != 33 || in_sizes[0] != MX * D || out_size != MX * D || ws_size < WS_END) { fprintf(stderr, "kernel_launch: shape/workspace mismatch (n_in %d, ws %zu < %zu)\n", n_in, ws_size, (size_t)WS_END); grid = -1; return; }
        int dev = 0, cus = 0, per_cu = 0;
        if (hipGetDevice(&dev) != hipSuccess || hipDeviceGetAttribute(&cus, hipDeviceAttributeMultiprocessorCount, dev) != hipSuccess) { grid = -1; return; }
        if (hipFuncSetAttribute((const void*)hymba_fwd, hipFuncAttributeMaxDynamicSharedMemorySize, LDS_BYTES) != hipSuccess) { fprintf(stderr, "kernel_launch: hipFuncSetAttribute failed\n"); grid = -1; return; }
        if (hipOccupancyMaxActiveBlocksPerMultiprocessor(&per_cu, (const void*)hymba_fwd, NTHR, LDS_BYTES) != hipSuccess || per_cu < 1) fprintf(stderr, "kernel_launch: occupancy query says %d\n", per_cu);
        (void)hipGetLastError();
        grid = cus;
    }
    if (grid < 0) return;
    if (hipMemsetAsync((char*)d_ws + WS_CTL, 0, CTL_ZERO_BYTES, stream) != hipSuccess) return;
    Args a{};
    for (int i = 0; i < 33; ++i) a.in[i] = (const float*)d_in[i];
    a.out = (float*)d_out; a.ws = (unsigned char*)d_ws;
    if (MK_N_LAUNCHES == 1) { a.ph_lo = 0; a.ph_hi = N_PHASES; hipLaunchKernelGGL(hymba_fwd, dim3(grid), dim3(NTHR), LDS_BYTES, stream, a); }
    else for (int p = 0; p < N_PHASES; ++p) { a.ph_lo = p; a.ph_hi = p + 1; hipLaunchKernelGGL(hymba_fwd, dim3(grid), dim3(NTHR), LDS_BYTES, stream, a); }
    const hipError_t le = hipPeekAtLastError();
    if (le != hipSuccess) fprintf(stderr, "kernel_launch: launch failed: %s\n", hipGetErrorName(le));
}
```

```cpp
#include <hip/hip_runtime.h>
#include <cstdio>
#include <cstdint>

#ifndef PROBE_DUP
#define PROBE_DUP -1
#endif
#ifndef PROBE_SPIN
#define PROBE_SPIN -1
#endif
#ifndef PROBE_A
#define PROBE_A 30
#define PROBE_B 31
#define PROBE_MUL 1
#define PROBE_BLK 0
#endif
#ifndef PROBE_GP
#define PROBE_GP 2
#endif
#ifndef MK_N_LAUNCHES
#define MK_N_LAUNCHES 1
#endif

namespace pg8 {
#define PG8_LAS __attribute__((address_space(3)))
typedef unsigned short bf16_t;
typedef short bf16x8 __attribute__((ext_vector_type(8)));
typedef float f32x4 __attribute__((ext_vector_type(4)));
typedef unsigned u32x4 __attribute__((ext_vector_type(4)));
typedef int i32x4 __attribute__((ext_vector_type(4)));
template <bool I8> struct AccT { typedef f32x4 type; }; template <> struct AccT<true> { typedef i32x4 type; };
__device__ __forceinline__ f32x4 mma16(bf16x8 b, bf16x8 a, f32x4 c) { return __builtin_amdgcn_mfma_f32_16x16x32_bf16(b, a, c, 0, 0, 0); }
__device__ __forceinline__ i32x4 mma16(bf16x8 b, bf16x8 a, i32x4 c) { return __builtin_amdgcn_mfma_i32_16x16x64_i8(__builtin_bit_cast(i32x4, b), __builtin_bit_cast(i32x4, a), c, 0, 0, 0); }
constexpr int BM = 256, BK = 64, HALF = 128, HTB = HALF * BK * 2, STAGE_BYTES = 8 * HTB, NXCD = 8, WGM = 8;

__host__ __device__ __forceinline__ int lds_byte(int r, int c) { const int st = (r >> 4) * 2 + (c >> 5), rr = r & 15, cc = c & 31, ob = rr * 64 + cc * 2; return st * 1024 + (ob ^ (((ob >> 9) & 1) << 5)); }
__host__ __device__ __forceinline__ void stage_rc(int b, int& R, int& C) { const int st = b / 1024, sb = b % 1024, swz = sb ^ (((sb >> 9) & 1) << 5); R = (st >> 1) * 16 + swz / 64; C = (st & 1) * 32 + (swz % 64) / 2; }
__host__ __device__ __forceinline__ int perm32(int rho) { const int n = rho >> 4, i = rho & 15; return 8 * (i >> 2) + 4 * n + (i & 3); }

__device__ __forceinline__ int lane_id_opaque() { int l; asm volatile("v_mbcnt_lo_u32_b32 %0, -1, 0\n\tv_mbcnt_hi_u32_b32 %0, -1, %0" : "=v"(l)); return l; }
struct Unit { int pm, pn; };
struct Gemm { const bf16_t* A; const bf16_t* Bt; int lda, ldb, K, a_shift; unsigned a_stride; };

struct StaticOrder {
    int nM, nN, nwg, G, c, chunked, wb, rev, single;
    __device__ __forceinline__ void init(int nM_, int nN_, int G_, int c_, int chunked_ = 0, int wb_ = 16, int rev_ = 0) { nM = nM_; nN = nN_; nwg = nM * nN; G = G_; c = c_; chunked = chunked_; wb = wb_; rev = rev_; single = -1; }
    __device__ __forceinline__ bool next(int i, Unit& u) const {
        const long L = (single >= 0) ? (i == 0 ? (long)single : (long)nwg) : (long)i * G + c; if (L >= nwg) return false;
        if (chunked) { const int CP = chunked, per_chunk = CP * nN, nch = nM / CP;
            int ch = (int)L / per_chunk, w = (int)L % per_chunk;
            if (ch >= nch) { const int e = (int)L - nch * per_chunk; u.pm = nch * CP + e / nN; u.pn = e % nN; return true; }
            if (rev) ch = nch - 1 - ch;
            const int full = (nN / wb) * CP * wb; int jb, r, wbj;
            if (w < full) { jb = w / (CP * wb); r = w % (CP * wb); wbj = wb; } else { jb = nN / wb; r = w - full; wbj = nN % wb; }
            const int gy = 32 / CP, xcd = r & 7, loc = r >> 3, pq = wbj / gy;
            u.pm = ch * CP + (xcd / gy) * 4 + (loc & 3); u.pn = jb * wb + (xcd % gy) * pq + (loc >> 2); return true; }
        int wgid = (int)L; { const int q = nwg / NXCD, r = nwg % NXCD, xcd = wgid % NXCD, off = wgid / NXCD; wgid = (xcd < r ? xcd * (q + 1) : r * (q + 1) + (xcd - r) * q) + off; }
        const int nig = WGM * nN, gid = wgid / nig, fm = gid * WGM, gsz = (nM - fm) < WGM ? (nM - fm) : WGM;
        u.pm = fm + ((wgid % nig) % gsz); u.pn = (wgid % nig) / gsz; return true;
    }
};

__device__ __forceinline__ unsigned cvt_pk_bf16(float lo, float hi) { unsigned r; asm volatile("v_cvt_pk_bf16_f32 %0, %1, %2" : "=v"(r) : "v"(lo), "v"(hi)); return r; }

template <class Epi, bool ALIGN_EPI, bool SP2, bool HOOK = false, bool STAMPS = false, bool I8 = false>
__device__ __forceinline__ void gemm_phase(PG8_LAS unsigned char* lds, const int wid, const Gemm g, const StaticOrder& S, const Epi& E, const unsigned long long* hss = nullptr, float hinv = 0.f, float heps = 0.f, unsigned long long* st = nullptr) {
    const int lane = lane_id_opaque(), tid = wid * 64 + lane, wr = wid >> 2, wc = wid & 3, fr = lane & 15, fq = lane >> 4;
    const int K = g.K, nt = K / BK;
    unsigned voffA[2], voffB[2];
#pragma unroll
    for (int i = 0; i < 2; ++i) { int R, C; stage_rc(tid * 16 + i * 8192, R, C); const int Rb = (R & ~31) + perm32(R & 31);
        voffA[i] = (unsigned)(R * g.lda + C) * 2u; voffB[i] = (unsigned)(Rb * g.ldb + C) * 2u; }
    const size_t kstep = (size_t)(BK * 2);
    const size_t hA = (size_t)HALF * g.lda * 2, hB = (size_t)HALF * g.ldb * 2;
    const size_t tA = 2 * hA, tB = 2 * hB;
    const unsigned ldsw = (unsigned)wid * 1024u;
    const int aoff = lds_byte(wr * 64 + fr, fq * 8), boff = lds_byte(wc * 32 + fr, fq * 8);
#define PG8_SA(b, h) (((b) * 2 + (h)) * HTB)
#define PG8_SB(b, h) ((4 + (b) * 2 + (h)) * HTB)
#define PG8_STAGE(bufoff, gbase, voff) do { _Pragma("unroll") for (int _i = 0; _i < 2; ++_i) \
        __builtin_amdgcn_global_load_lds((const unsigned*)((const char*)(gbase) + (voff)[_i]), (PG8_LAS unsigned*)(lds + (bufoff) + ldsw + _i * 8192), 16, 0, 0); } while (0)
#define PG8_LDA(dst, b, h) do { _Pragma("unroll") for (int m = 0; m < 4; ++m) _Pragma("unroll") for (int k = 0; k < 2; ++k) dst[m][k] = *(const PG8_LAS bf16x8*)(lds + PG8_SA(b, h) + aoff + m * 2048 + k * 1024); } while (0)
#define PG8_LDB(dst, b, h) do { _Pragma("unroll") for (int n = 0; n < 2; ++n) _Pragma("unroll") for (int k = 0; k < 2; ++k) dst[n][k] = *(const PG8_LAS bf16x8*)(lds + PG8_SB(b, h) + boff + n * 2048 + k * 1024); } while (0)
#define PG8_MMA(ai, bj, At, Bt) do { __builtin_amdgcn_s_setprio(1); _Pragma("unroll") for (int m = 0; m < 4; ++m) _Pragma("unroll") for (int n = 0; n < 2; ++n) _Pragma("unroll") for (int k = 0; k < 2; ++k) \
        acc[ai][bj][m][n] = mma16(Bt[n][k], At[m][k], acc[ai][bj][m][n]); __builtin_amdgcn_s_setprio(0); } while (0)
#define PG8_WAIT_V(n) asm volatile("s_waitcnt vmcnt(" #n ")" ::: "memory")
#define PG8_WAIT_L(n) asm volatile("s_waitcnt lgkmcnt(" #n ")" ::: "memory")
#define PG8_BAR __builtin_amdgcn_s_barrier()
#define PG8_SCHED __builtin_amdgcn_sched_barrier(0)
#define PG8_ST(k) do { if constexpr (STAMPS) { if (wid == 0 && lane == 0 && blockIdx.x == PROBE_BLK) st[k] = wall_clock64(); } } while (0)
    Unit cur, nxt; int ui = 0;
    if (!S.next(0, cur)) return;
    PG8_ST(0);
    typedef typename AccT<I8>::type acc_t; static_assert(!(I8 && HOOK), "no float hook on integer accumulators");
    acc_t acc[2][2][4][2];
#pragma unroll
    for (int a = 0; a < 2; ++a)
#pragma unroll
        for (int b = 0; b < 2; ++b)
#pragma unroll
            for (int m = 0; m < 4; ++m)
#pragma unroll
                for (int n = 0; n < 2; ++n) acc[a][b][m][n] = (acc_t){0, 0, 0, 0};
    bf16x8 At[4][2], B0[2][2], B1[2][2];
    const char* cA = (const char*)g.A + (size_t)cur.pm * tA + (size_t)(cur.pn >> g.a_shift) * g.a_stride; const char* cB = (const char*)g.Bt + (size_t)cur.pn * tB;
    if constexpr (SP2) {
        PG8_STAGE(PG8_SB(0, 0), cB, voffB); PG8_STAGE(PG8_SB(0, 1), cB + hB, voffB); PG8_STAGE(PG8_SA(0, 0), cA, voffA); PG8_STAGE(PG8_SA(0, 1), cA + hA, voffA);
        if (wr == 1) PG8_BAR;
        PG8_WAIT_V(2); PG8_BAR;
        PG8_STAGE(PG8_SB(1, 0), cB + kstep, voffB); PG8_STAGE(PG8_SA(1, 0), cA + kstep, voffA); PG8_STAGE(PG8_SB(1, 1), cB + hB + kstep, voffB);
        PG8_WAIT_V(6); PG8_BAR;
    } else {
        PG8_STAGE(PG8_SB(0, 0), cB, voffB); PG8_STAGE(PG8_SA(0, 0), cA, voffA); PG8_STAGE(PG8_SB(0, 1), cB + hB, voffB); PG8_STAGE(PG8_SA(0, 1), cA + hA, voffA);
        if (wr == 1) PG8_BAR;
        PG8_WAIT_V(4); PG8_BAR;
        PG8_STAGE(PG8_SB(1, 0), cB + kstep, voffB); PG8_STAGE(PG8_SA(1, 0), cA + kstep, voffA); PG8_STAGE(PG8_SB(1, 1), cB + hB + kstep, voffB);
        PG8_WAIT_V(6); PG8_BAR;
    }
    PG8_ST(1);
    for (;;) {
        const bool has_next = S.next(ui + 1, nxt);
        const char* nA = has_next ? (const char*)g.A + (size_t)nxt.pm * tA + (size_t)(nxt.pn >> g.a_shift) * g.a_stride : cA; const char* nB = has_next ? (const char*)g.Bt + (size_t)nxt.pn * tB : cB;
#pragma nounroll
        for (int t = 0; t < nt; t += 2) {
            const bool last = (t == nt - 2);
            if constexpr (HOOK) { if (t == (nt >> 1)) {
                float hsc[2][4];
#pragma unroll
                for (int a_ = 0; a_ < 2; ++a_)
#pragma unroll
                    for (int m_ = 0; m_ < 4; ++m_) hsc[a_][m_] = __builtin_amdgcn_rsqf((float)hss[cur.pm * 256 + a_ * 128 + wr * 64 + m_ * 16 + fr] * 2.3283064365386963e-10f * hinv + heps);
#pragma unroll
                for (int a_ = 0; a_ < 2; ++a_)
#pragma unroll
                    for (int b_ = 0; b_ < 2; ++b_)
#pragma unroll
                        for (int m_ = 0; m_ < 4; ++m_)
#pragma unroll
                            for (int n_ = 0; n_ < 2; ++n_) acc[a_][b_][m_][n_] *= hsc[a_][m_]; } }
            const char* a1 = cA + (size_t)(t + 1) * kstep;
            const char* a2 = last ? nA : cA + (size_t)(t + 2) * kstep; const char* b2 = last ? nB : cB + (size_t)(t + 2) * kstep;
            const char* a3 = a2 + kstep; const char* b3 = b2 + kstep;
            if constexpr (SP2) {
            PG8_LDB(B0, 0, 0); PG8_LDB(B1, 0, 1); PG8_SCHED; PG8_LDA(At, 0, 0); PG8_STAGE(PG8_SA(1, 1), a1 + hA, voffA);
            PG8_WAIT_V(8); PG8_WAIT_L(0); PG8_BAR; PG8_MMA(0, 0, At, B0); PG8_MMA(0, 1, At, B1); PG8_BAR; PG8_SCHED;
            PG8_LDA(At, 0, 1); PG8_STAGE(PG8_SB(0, 0), b2, voffB); PG8_STAGE(PG8_SB(0, 1), b2 + hB, voffB); PG8_STAGE(PG8_SA(0, 0), a2, voffA);
            PG8_WAIT_V(8); PG8_WAIT_L(0); PG8_BAR; PG8_MMA(1, 0, At, B0); PG8_MMA(1, 1, At, B1); PG8_BAR; PG8_SCHED;
            PG8_LDB(B0, 1, 0); PG8_LDB(B1, 1, 1); PG8_SCHED; PG8_LDA(At, 1, 0); PG8_STAGE(PG8_SA(0, 1), a2 + hA, voffA);
            PG8_WAIT_V(8); PG8_WAIT_L(0); PG8_BAR; PG8_MMA(0, 0, At, B0); PG8_MMA(0, 1, At, B1); PG8_BAR; PG8_SCHED;
            PG8_LDA(At, 1, 1); PG8_STAGE(PG8_SB(1, 0), b3, voffB); PG8_STAGE(PG8_SB(1, 1), b3 + hB, voffB); PG8_STAGE(PG8_SA(1, 0), a3, voffA);
            PG8_WAIT_V(8); PG8_WAIT_L(0); PG8_BAR; PG8_MMA(1, 0, At, B0); PG8_MMA(1, 1, At, B1); PG8_BAR; PG8_SCHED;
            } else {
            PG8_LDB(B0, 0, 0); PG8_SCHED; PG8_LDA(At, 0, 0); PG8_STAGE(PG8_SA(1, 1), a1 + hA, voffA);
            PG8_WAIT_L(8); PG8_BAR; PG8_WAIT_L(0); PG8_MMA(0, 0, At, B0); PG8_BAR; PG8_SCHED;
            PG8_LDB(B1, 0, 1); PG8_STAGE(PG8_SB(0, 0), b2, voffB);
            PG8_BAR; PG8_WAIT_L(0); PG8_MMA(0, 1, At, B1); PG8_BAR;
            PG8_LDA(At, 0, 1); PG8_STAGE(PG8_SA(0, 0), a2, voffA);
            PG8_BAR; PG8_WAIT_L(0); PG8_MMA(1, 0, At, B0); PG8_BAR; PG8_SCHED;
            PG8_STAGE(PG8_SB(0, 1), b2 + hB, voffB);
            PG8_WAIT_V(6); PG8_BAR; PG8_MMA(1, 1, At, B1); PG8_BAR;
            PG8_LDB(B0, 1, 0); PG8_SCHED; PG8_LDA(At, 1, 0); PG8_STAGE(PG8_SA(0, 1), a2 + hA, voffA);
            PG8_WAIT_L(8); PG8_BAR; PG8_WAIT_L(0); PG8_MMA(0, 0, At, B0); PG8_BAR; PG8_SCHED;
            PG8_LDB(B1, 1, 1); PG8_STAGE(PG8_SB(1, 0), b3, voffB);
            PG8_BAR; PG8_WAIT_L(0); PG8_MMA(0, 1, At, B1); PG8_BAR;
            PG8_LDA(At, 1, 1); PG8_STAGE(PG8_SA(1, 0), a3, voffA);
            PG8_BAR; PG8_WAIT_L(0); PG8_MMA(1, 0, At, B0); PG8_BAR; PG8_SCHED;
            PG8_STAGE(PG8_SB(1, 1), b3 + hB, voffB);
            PG8_WAIT_V(6); PG8_BAR; PG8_MMA(1, 1, At, B1); PG8_BAR;
            }
        }
        PG8_ST(2 + 2 * ui);
        if constexpr (ALIGN_EPI) { if (wr == 0) PG8_BAR; }
        E(acc, cur, wr, wc, fr, fq);
        PG8_ST(3 + 2 * ui);
        if (!has_next) break;
#pragma unroll
        for (int a = 0; a < 2; ++a)
#pragma unroll
            for (int b = 0; b < 2; ++b)
#pragma unroll
                for (int m = 0; m < 4; ++m)
#pragma unroll
                    for (int n = 0; n < 2; ++n) acc[a][b][m][n] = (acc_t){0, 0, 0, 0};
        cur = nxt; cA = nA; cB = nB; ++ui;
        if constexpr (ALIGN_EPI) { if (wr == 1) PG8_BAR; }
    }
    PG8_WAIT_V(0);
    if constexpr (!ALIGN_EPI) { if (wr == 0) PG8_BAR; }
    PG8_BAR;
#undef PG8_ST
#undef PG8_SA
#undef PG8_SB
#undef PG8_STAGE
#undef PG8_LDA
#undef PG8_LDB
#undef PG8_MMA
#undef PG8_WAIT_V
#undef PG8_WAIT_L
#undef PG8_BAR
#undef PG8_SCHED
}
}

constexpr int NWAVES = 8, NTHR = 512;
constexpr int D = 4096, FF = 11008, MX = 16384, MP = 16640, NPX = 64, NPP = 65;
constexpr int DR = 2048, DS = 2048, NG = 128, SL = 16  , NCHX = 1024, NCHP = 1040, UK = 384  ;
constexpr int NSEG = 32, SEGL = 128;
constexpr float EPS = 1e-6f;
constexpr int N_PHASES = 15;

constexpr size_t MiB = 1u << 20;
constexpr size_t CTL_ZERO_BYTES = 2 * MiB;
constexpr size_t al(size_t x) { return (x + MiB - 1) / MiB * MiB; }
constexpr size_t WS_CTL = 0;
constexpr size_t WS_W1GU = al(WS_CTL + CTL_ZERO_BYTES);
constexpr size_t WS_W1D  = al(WS_W1GU + (size_t)2 * FF * D * 2);
constexpr size_t WS_WIN  = al(WS_W1D + (size_t)D * FF * 2);
constexpr size_t WS_WRG  = al(WS_WIN + (size_t)6144 * D * 2);
constexpr size_t WS_WGLU = al(WS_WRG + (size_t)4096 * 256 * 2);
constexpr size_t WS_WOUT = al(WS_WGLU + (size_t)DS * DS * 2);
constexpr size_t WS_S5TQ = al(WS_WOUT + (size_t)D * D * 2);
constexpr size_t WS_S5P  = al(WS_S5TQ + (size_t)NG * 256 * UK * 2);
constexpr size_t WS_S5BB = al(WS_S5P + (size_t)NG * 256 * 256 * 2);
constexpr size_t WS_S5LAM = al(WS_S5BB + (size_t)NG * 64 * 16 * 2 * 4);
constexpr size_t WS_SEG  = al(WS_S5LAM + (size_t)NG * 64 * 4 * 4);
constexpr size_t WS_C8   = al(WS_SEG + (size_t)2 * 4 * NSEG * DR * 4);
constexpr size_t WS_SW   = al(WS_C8 + (size_t)DR * 4);
constexpr size_t WS_H0M  = al(WS_SW + MiB);
constexpr size_t WS_AX   = al(WS_H0M + (size_t)256 * D * 4);
constexpr size_t WS_AX2  = al(WS_AX + (size_t)MP * D * 2);
constexpr size_t WS_H    = al(WS_AX2 + (size_t)MP * D * 2);
constexpr size_t WS_HB   = al(WS_H + (size_t)MP * FF * 2);
constexpr size_t WS_END  = al(WS_HB + (size_t)MP * D * 2);
constexpr size_t WS_GG   = WS_H;
constexpr size_t WS_U    = al(WS_GG + (size_t)MP * DR * 2);
constexpr size_t WS_XCB  = al(WS_U + (size_t)NG * NCHP * UK * 2);
constexpr size_t WS_Z    = al(WS_XCB + (size_t)MP * DR * 2);
static_assert(WS_Z + (size_t)MX * DS * 2 <= WS_HB, "mixer overlays fit in H");
constexpr size_t DO_UA = 0, DO_URG = al((size_t)MP * DR * 2), DO_E = al(DO_URG + (size_t)MP * DR * 2);
static_assert(DO_E + (size_t)NG * NCHX * 128 * 4 <= (size_t)MX * D * 4, "d_out scratch");
constexpr int CW_BAR = 4096;
constexpr int CW_SS = 65536;
constexpr int CW_CM = CW_SS + 8 * MP + 64;
constexpr int CW_CMD = CW_CM + 4 * FF;
constexpr int CW_HM = CW_CMD + D;
static_assert((CW_HM + MX) * 4 <= (int)CTL_ZERO_BYTES && (CW_SS % 2) == 0, "ctl");

constexpr int RING_BYTES = 131072, MISC_OFF = RING_BYTES + 320, LDS_BYTES = 147456;

#define LAS __attribute__((address_space(3)))
typedef unsigned short bf16;
typedef unsigned v4u __attribute__((ext_vector_type(4)));
typedef unsigned v2u __attribute__((ext_vector_type(2)));
typedef float f32x4 __attribute__((ext_vector_type(4)));
typedef float f32x2 __attribute__((ext_vector_type(2)));
#define LDS_WAIT() asm volatile("s_waitcnt lgkmcnt(0)" ::: "memory")
#define VM_WAIT() asm volatile("s_waitcnt vmcnt(0)" ::: "memory")
using pg8::cvt_pk_bf16;
__device__ __forceinline__ float bf_lo(unsigned w) { return __uint_as_float(w << 16); }
__device__ __forceinline__ float bf_hi(unsigned w) { return __uint_as_float(w & 0xffff0000u); }
__device__ __forceinline__ float fsigmoid(float v) { return __builtin_amdgcn_rcpf(1.0f + __builtin_amdgcn_exp2f(-1.4426950408889634f * v)); }
__device__ __forceinline__ float gelu_tanh(float x) { const float u = x * (1.0f + 0.044715f * x * x); return x * fsigmoid(1.5957691216057308f * u); }
__device__ __forceinline__ float wave_sum(float v) {
#pragma unroll
    for (int o = 1; o < 64; o <<= 1) v += __shfl_xor(v, o);
    return v;
}

typedef unsigned long long u64;
__device__ __forceinline__ void ss_add(u64* p, float s) { atomicAdd(p, (u64)(s * 4294967296.0f)); }
__device__ __forceinline__ float ss_get(const u64* p) { return (float)(*p) * 2.3283064365386963e-10f; }

#define XB_TMO      128
#define XB_XCNT(j)  (256  + 64 * (j))
#define XB_XSUB(j)  (1280 + 64 * (j))
#define XB_XGEN(j)  (2304 + 64 * (j))
#define XB_TOP      3328
#define XB_TOPGEN   3392
#define XCD_BAR_WORDS 3456
#define XB_SPIN_CAP (1u << 18)
__device__ __forceinline__ unsigned xb_ld(unsigned* p)              { return __hip_atomic_load(p, __ATOMIC_RELAXED, __HIP_MEMORY_SCOPE_AGENT); }
__device__ __forceinline__ unsigned xb_add(unsigned* p, unsigned v) { return __hip_atomic_fetch_add(p, v, __ATOMIC_RELAXED, __HIP_MEMORY_SCOPE_AGENT); }
__device__ __forceinline__ unsigned xb_xcc_id() { return (unsigned)__builtin_amdgcn_s_getreg((3 << 11) | 20) & 0xFu; }
#define XB_SPIN(cond, bar) do { unsigned _sp = 0; while (cond) { __builtin_amdgcn_s_sleep(1); \
    if ((++_sp & 255u) == 0u) { if (xb_ld(&(bar)[XB_TMO])) break; if (_sp > XB_SPIN_CAP) { atomicAdd(&(bar)[XB_TMO], 1u); break; } } } } while (0)
struct XcdBarrier { unsigned* bar; unsigned x; volatile LAS unsigned* st; };
__device__ __forceinline__ XcdBarrier xcd_barrier_post(unsigned* bar, volatile LAS unsigned* st) {
    XcdBarrier b; b.bar = bar; b.x = xb_xcc_id(); b.st = st;
    if (threadIdx.x == 0) (void)xb_add(&bar[XB_XCNT(b.x)], 1u);
    return b;
}
__device__ __forceinline__ void xcd_barrier_complete(unsigned* bar, unsigned x, unsigned& nloc, unsigned& nx) {
    const unsigned G = gridDim.x * gridDim.y * gridDim.z;
    unsigned sum, cnt, mine, sp = 0u;
    for (;;) {
        sum = 0u; cnt = 0u; mine = 0u;
#pragma unroll
        for (unsigned j = 0; j < 16; ++j) { const unsigned c = xb_ld(&bar[XB_XCNT(j)]); sum += c; cnt += (c > 0u) ? 1u : 0u; mine = (j == x) ? c : mine; }
        if (sum == G) break;
        __builtin_amdgcn_s_sleep(1);
        if ((++sp & 255u) == 0u) { if (xb_ld(&bar[XB_TMO])) break; if (sp > XB_SPIN_CAP) { atomicAdd(&bar[XB_TMO], 1u); break; } }
    }
    nloc = mine > 0u ? mine : 1u; nx = cnt > 0u ? cnt : 1u;
}
__device__ __forceinline__ void xcd_barrier(const XcdBarrier& b) {
    asm volatile("s_waitcnt vmcnt(0)" ::: "memory");
    __syncthreads();
    if (threadIdx.x == 0) {
        unsigned* bar = b.bar;
        __builtin_amdgcn_s_waitcnt(0);
        unsigned nloc = b.st[0], nx = b.st[1];
        if (nloc == 0u) { xcd_barrier_complete(bar, b.x, nloc, nx); b.st[0] = nloc; b.st[1] = nx; }
        const unsigned old = xb_add(&bar[XB_XSUB(b.x)], 1u);
        const unsigned gen = old / nloc;
        if (old + 1u == (gen + 1u) * nloc) {
            __builtin_amdgcn_fence(__ATOMIC_RELEASE, "agent");
            asm volatile("s_waitcnt vmcnt(0)" ::: "memory");
            const unsigned og = xb_add(&bar[XB_TOP], 1u);
            const unsigned tg = og / nx;
            if (og + 1u == (tg + 1u) * nx) xb_add(&bar[XB_TOPGEN], 1u);
            else XB_SPIN(xb_ld(&bar[XB_TOPGEN]) == tg, bar);
            __builtin_amdgcn_fence(__ATOMIC_ACQUIRE, "agent");
            xb_add(&bar[XB_XGEN(b.x)], 1u);
            asm volatile("s_waitcnt vmcnt(0)" ::: "memory");
        } else {
            XB_SPIN(xb_ld(&bar[XB_XGEN(b.x)]) == gen, bar);
            __builtin_amdgcn_fence(__ATOMIC_ACQUIRE, "agent");
            asm volatile("s_waitcnt vmcnt(0)" ::: "memory");
        }
    }
    __syncthreads();
}

using pg8::Unit;
#define EPI_ARGS const f32x4 (&acc)[2][2][4][2], const Unit& u, int wr, int wc, int fr, int fq
#define ROWLOOP _Pragma("unroll") for (int ai = 0; ai < 2; ++ai) _Pragma("unroll") for (int m = 0; m < 4; ++m)

template <bool RS> struct EpiSwiglu {
    bf16* H; const u64* ss;
    __device__ __forceinline__ void operator()(EPI_ARGS) const {
        const int row0 = u.pm * 256 + wr * 64 + fr, j0 = u.pn * 128 + wc * 32 + 8 * fq;
        ROWLOOP { const int row = row0 + ai * 128 + m * 16;
            float rs = 1.0f; if (RS) rs = __builtin_amdgcn_rsqf(ss_get(ss + row) * (1.0f / D) + EPS);
            float h[8];
#pragma unroll
            for (int n = 0; n < 2; ++n)
#pragma unroll
                for (int e = 0; e < 4; ++e) { const float gv = acc[ai][0][m][n][e] * rs, uv = acc[ai][1][m][n][e] * rs; h[n * 4 + e] = gv * uv * fsigmoid(gv); }
            v4u w; w.x = cvt_pk_bf16(h[0], h[1]); w.y = cvt_pk_bf16(h[2], h[3]); w.z = cvt_pk_bf16(h[4], h[5]); w.w = cvt_pk_bf16(h[6], h[7]);
            *(v4u*)(H + (size_t)row * FF + j0) = w; }
    }
};
#define EPI_ARGS_I8 const pg8::i32x4 (&acc)[2][2][4][2], const Unit& u, int wr, int wc, int fr, int fq
template <bool RS> struct EpiSwigluI8 {
    bf16* H; const float* sa; const u64* ss; const float* sw; unsigned* hmax;
    __device__ __forceinline__ void operator()(EPI_ARGS_I8) const {
        const int row0 = u.pm * 256 + wr * 64 + fr, j0 = u.pn * 128 + wc * 32 + 8 * fq, b0 = u.pn * 256 + wc * 32 + 8 * fq;
        const f32x4 sg0 = *(const f32x4*)(sw + b0), sg1 = *(const f32x4*)(sw + b0 + 4), su0 = *(const f32x4*)(sw + b0 + 128), su1 = *(const f32x4*)(sw + b0 + 132);
        ROWLOOP { const int row = row0 + ai * 128 + m * 16;
            float rs = sa[row]; if (RS) rs *= __builtin_amdgcn_rsqf(ss_get(ss + row) * (1.0f / D) + EPS);
            float h[8];
#pragma unroll
            for (int e = 0; e < 4; ++e) { { const float gv = (float)acc[ai][0][m][0][e] * rs * sg0[e], uv = (float)acc[ai][1][m][0][e] * rs * su0[e]; h[e] = gv * uv * fsigmoid(gv); }
                                          { const float gv = (float)acc[ai][0][m][1][e] * rs * sg1[e], uv = (float)acc[ai][1][m][1][e] * rs * su1[e]; h[4 + e] = gv * uv * fsigmoid(gv); } }
            v4u w; w.x = cvt_pk_bf16(h[0], h[1]); w.y = cvt_pk_bf16(h[2], h[3]); w.z = cvt_pk_bf16(h[4], h[5]); w.w = cvt_pk_bf16(h[6], h[7]);
            *(v4u*)(H + (size_t)row * FF + j0) = w;
            if (hmax) { float mx = fmaxf(fmaxf(fmaxf(fabsf(h[0]), fabsf(h[1])), fmaxf(fabsf(h[2]), fabsf(h[3]))), fmaxf(fmaxf(fabsf(h[4]), fabsf(h[5])), fmaxf(fabsf(h[6]), fabsf(h[7]))));
                mx = fmaxf(mx, __shfl_xor(mx, 16)); mx = fmaxf(mx, __shfl_xor(mx, 32)); if (fq == 0) atomicMax(hmax + row, __float_as_uint(mx)); } }
    }
};
template <bool BASE_F32, bool FINAL> struct EpiResidB {
    const void* base; bf16* out; const float* gain; u64* ss;
    __device__ __forceinline__ void operator()(EPI_ARGS) const {
        const int row0 = u.pm * 256 + wr * 64 + fr;
        float sq[2][4];
        ROWLOOP sq[ai][m] = 0.f;
#pragma unroll
        for (int bj = 0; bj < 2; ++bj) { const int c0 = u.pn * 256 + bj * 128 + wc * 32 + 8 * fq;
            f32x4 g0 = {1.f, 1.f, 1.f, 1.f}, g1 = g0; if (FINAL) { g0 = *(const f32x4*)(gain + c0); g1 = *(const f32x4*)(gain + c0 + 4); }
#pragma unroll
            for (int ai = 0; ai < 2; ++ai) { f32x4 bq[4][2];
#pragma unroll
            for (int m = 0; m < 4; ++m) { const size_t off = (size_t)(row0 + ai * 128 + m * 16) * D + c0;
                if (BASE_F32) { bq[m][0] = *(const f32x4*)((const float*)base + off); bq[m][1] = *(const f32x4*)((const float*)base + off + 4); }
                else { const v4u w = *(const v4u*)((const bf16*)base + off); bq[m][0] = (f32x4){bf_lo(w.x), bf_hi(w.x), bf_lo(w.y), bf_hi(w.y)}; bq[m][1] = (f32x4){bf_lo(w.z), bf_hi(w.z), bf_lo(w.w), bf_hi(w.w)}; } }
#pragma unroll
            for (int m = 0; m < 4; ++m) { const size_t off = (size_t)(row0 + ai * 128 + m * 16) * D + c0;
                const f32x4 v0 = bq[m][0] + acc[ai][bj][m][0], v1 = bq[m][1] + acc[ai][bj][m][1];
                sq[ai][m] += (v0[0] * v0[0] + v0[1] * v0[1]) + (v0[2] * v0[2] + v0[3] * v0[3]) + (v1[0] * v1[0] + v1[1] * v1[1]) + (v1[2] * v1[2] + v1[3] * v1[3]);
                const f32x4 w0 = v0 * g0, w1 = v1 * g1;
                v4u w; w.x = cvt_pk_bf16(w0[0], w0[1]); w.y = cvt_pk_bf16(w0[2], w0[3]); w.z = cvt_pk_bf16(w1[0], w1[1]); w.w = cvt_pk_bf16(w1[2], w1[3]); *(v4u*)(out + off) = w; } } }
        ROWLOOP { float s = sq[ai][m]; s += __shfl_xor(s, 16); s += __shfl_xor(s, 32);
            if (fq == 0) ss_add(ss + row0 + ai * 128 + m * 16, s); }
    }
};
struct EpiResidI8 {
    const bf16* base; bf16* out; const float* gain; u64* ss; const float* sh; const float* sw;
    __device__ __forceinline__ void operator()(EPI_ARGS_I8) const {
        const int row0 = u.pm * 256 + wr * 64 + fr;
        float sq[2][4], rsc[2][4];
        ROWLOOP { sq[ai][m] = 0.f; rsc[ai][m] = sh[row0 + ai * 128 + m * 16]; }
#pragma unroll
        for (int bj = 0; bj < 2; ++bj) { const int c0 = u.pn * 256 + bj * 128 + wc * 32 + 8 * fq;
            const f32x4 g0 = *(const f32x4*)(gain + c0), g1 = *(const f32x4*)(gain + c0 + 4), s0 = *(const f32x4*)(sw + c0), s1 = *(const f32x4*)(sw + c0 + 4);
#pragma unroll
            for (int ai = 0; ai < 2; ++ai) { v4u bq[4];
#pragma unroll
            for (int m = 0; m < 4; ++m) bq[m] = *(const v4u*)(base + (size_t)(row0 + ai * 128 + m * 16) * D + c0);
#pragma unroll
            for (int m = 0; m < 4; ++m) { const size_t off = (size_t)(row0 + ai * 128 + m * 16) * D + c0; const v4u w = bq[m]; const float r = rsc[ai][m];
                const f32x4 b0 = {bf_lo(w.x), bf_hi(w.x), bf_lo(w.y), bf_hi(w.y)}, b1 = {bf_lo(w.z), bf_hi(w.z), bf_lo(w.w), bf_hi(w.w)};
                f32x4 v0, v1;
#pragma unroll
                for (int e = 0; e < 4; ++e) { v0[e] = b0[e] + (float)acc[ai][bj][m][0][e] * r * s0[e]; v1[e] = b1[e] + (float)acc[ai][bj][m][1][e] * r * s1[e]; }
                sq[ai][m] += (v0[0] * v0[0] + v0[1] * v0[1]) + (v0[2] * v0[2] + v0[3] * v0[3]) + (v1[0] * v1[0] + v1[1] * v1[1]) + (v1[2] * v1[2] + v1[3] * v1[3]);
                const f32x4 w0 = v0 * g0, w1 = v1 * g1;
                v4u o; o.x = cvt_pk_bf16(w0[0], w0[1]); o.y = cvt_pk_bf16(w0[2], w0[3]); o.z = cvt_pk_bf16(w1[0], w1[1]); o.w = cvt_pk_bf16(w1[2], w1[3]); *(v4u*)(out + off) = o; } } }
        ROWLOOP { float s = sq[ai][m]; s += __shfl_xor(s, 16); s += __shfl_xor(s, 32);
            if (fq == 0) ss_add(ss + row0 + ai * 128 + m * 16, s); }
    }
};
struct EpiWin {
    const u64* ss; bf16* urg; bf16* gg; bf16* U;
    __device__ __forceinline__ void operator()(EPI_ARGS) const {
        const int row0 = u.pm * 256 + wr * 64 + fr;
        ROWLOOP { const int row = row0 + ai * 128 + m * 16;
            const float rs = __builtin_amdgcn_rsqf(ss_get(ss + row) * (1.0f / D) + EPS);
#pragma unroll
            for (int bj = 0; bj < 2; ++bj) { const int c0 = u.pn * 256 + bj * 128 + wc * 32 + 8 * fq;
                const f32x4 v0 = acc[ai][bj][m][0] * rs, v1 = acc[ai][bj][m][1] * rs;
                if (u.pn < 8) { v4u w; w.x = cvt_pk_bf16(v0[0], v0[1]); w.y = cvt_pk_bf16(v0[2], v0[3]); w.z = cvt_pk_bf16(v1[0], v1[1]); w.w = cvt_pk_bf16(v1[2], v1[3]); *(v4u*)(urg + (size_t)row * DR + c0) = w; }
                else if (u.pn < 16) { v4u w; w.x = cvt_pk_bf16(gelu_tanh(v0[0]), gelu_tanh(v0[1])); w.y = cvt_pk_bf16(gelu_tanh(v0[2]), gelu_tanh(v0[3]));
                    w.z = cvt_pk_bf16(gelu_tanh(v1[0]), gelu_tanh(v1[1])); w.w = cvt_pk_bf16(gelu_tanh(v1[2]), gelu_tanh(v1[3])); *(v4u*)(gg + (size_t)row * DR + (c0 - 2048)) = w; }
                else { const int cs = c0 - 4096, g = cs >> 4, cp = cs & 15;
                    v4u w; w.x = cvt_pk_bf16(v0[0], v0[1]); w.y = cvt_pk_bf16(v0[2], v0[3]); w.z = cvt_pk_bf16(v1[0], v1[1]); w.w = cvt_pk_bf16(v1[2], v1[3]);
                    *(v4u*)(U + ((size_t)g * NCHP + (row >> 4)) * UK + (row & 15) * 16 + cp) = w; } } }
    }
};
__device__ __forceinline__ float one_minus_exp(float x) {
    const float big = 1.0f - __builtin_amdgcn_exp2f(1.4426950408889634f * x);
    const float small = -x * (1.0f + x * (0.5f + x * (0.16666667f + x * 0.041666668f)));
    return (x > -0.0625f) ? small : big;
}
struct EpiGates {
    const float* b_a; const float* b_x; const float* c8t; const bf16* xcb; bf16* LA; bf16* BX;
    __device__ __forceinline__ void operator()(EPI_ARGS) const {
        const int row0 = u.pm * 256 + wr * 64 + fr, ch0 = (u.pn >> 1) * 256 + (u.pn & 1) * 128 + wc * 32 + 8 * fq;
        const f32x4 ba0 = *(const f32x4*)(b_a + ch0), ba1 = *(const f32x4*)(b_a + ch0 + 4), bx0 = *(const f32x4*)(b_x + ch0), bx1 = *(const f32x4*)(b_x + ch0 + 4);
        const f32x4 c80 = *(const f32x4*)(c8t + ch0), c81 = *(const f32x4*)(c8t + ch0 + 4);
        v4u xq[2][4];
        ROWLOOP xq[ai][m] = *(const v4u*)(xcb + (size_t)(row0 + ai * 128 + m * 16) * DR + ch0);
        ROWLOOP { const size_t off = (size_t)(row0 + ai * 128 + m * 16) * DR + ch0; const v4u xw = xq[ai][m];
            const f32x4 x0 = {bf_lo(xw.x), bf_hi(xw.x), bf_lo(xw.y), bf_hi(xw.y)}, x1 = {bf_lo(xw.z), bf_hi(xw.z), bf_lo(xw.w), bf_hi(xw.w)};
            f32x4 l0, l1;
#pragma unroll
            for (int e = 0; e < 4; ++e) { l0[e] = c80[e] * fsigmoid(acc[ai][0][m][0][e] + ba0[e]); l1[e] = c81[e] * fsigmoid(acc[ai][0][m][1][e] + ba1[e]); }
            v4u lw; lw.x = cvt_pk_bf16(l0[0], l0[1]); lw.y = cvt_pk_bf16(l0[2], l0[3]); lw.z = cvt_pk_bf16(l1[0], l1[1]); lw.w = cvt_pk_bf16(l1[2], l1[3]);
            const f32x4 r0 = {bf_lo(lw.x), bf_hi(lw.x), bf_lo(lw.y), bf_hi(lw.y)}, r1 = {bf_lo(lw.z), bf_hi(lw.z), bf_lo(lw.w), bf_hi(lw.w)};
            f32x4 o0, o1;
#pragma unroll
            for (int e = 0; e < 4; ++e) { o0[e] = __builtin_amdgcn_sqrtf(one_minus_exp(2.0f * r0[e])) * fsigmoid(acc[ai][1][m][0][e] + bx0[e]) * x0[e];
                                          o1[e] = __builtin_amdgcn_sqrtf(one_minus_exp(2.0f * r1[e])) * fsigmoid(acc[ai][1][m][1][e] + bx1[e]) * x1[e]; }
            v4u ow; ow.x = cvt_pk_bf16(o0[0], o0[1]); ow.y = cvt_pk_bf16(o0[2], o0[3]); ow.z = cvt_pk_bf16(o1[0], o1[1]); ow.w = cvt_pk_bf16(o1[2], o1[3]);
            *(v4u*)(LA + off) = lw; *(v4u*)(BX + off) = ow; }
    }
};
struct EpiGatesL {
    const float* b_a; const float* b_x; const float* c8t; const bf16* xcb; LAS unsigned char* TL;
    __device__ __forceinline__ void operator()(EPI_ARGS) const {
        const int row0 = u.pm * 256 + wr * 64 + fr, ch0 = (u.pn >> 1) * 256 + (u.pn & 1) * 128 + wc * 32 + 8 * fq;
        const f32x4 ba0 = *(const f32x4*)(b_a + ch0), ba1 = *(const f32x4*)(b_a + ch0 + 4), bx0 = *(const f32x4*)(b_x + ch0), bx1 = *(const f32x4*)(b_x + ch0 + 4);
        const f32x4 c80 = *(const f32x4*)(c8t + ch0), c81 = *(const f32x4*)(c8t + ch0 + 4);
        v4u xq[2][4];
        ROWLOOP xq[ai][m] = *(const v4u*)(xcb + (size_t)(row0 + ai * 128 + m * 16) * DR + ch0);
        asm volatile("s_waitcnt vmcnt(0)" ::: "memory"); __builtin_amdgcn_s_barrier();
        const int lofs = ((wr * 64 + fr) * 128 + wc * 32 + 8 * fq) * 2;
        ROWLOOP { const v4u xw = xq[ai][m];
            const f32x4 x0 = {bf_lo(xw.x), bf_hi(xw.x), bf_lo(xw.y), bf_hi(xw.y)}, x1 = {bf_lo(xw.z), bf_hi(xw.z), bf_lo(xw.w), bf_hi(xw.w)};
            f32x4 l0, l1;
#pragma unroll
            for (int e = 0; e < 4; ++e) { l0[e] = c80[e] * fsigmoid(acc[ai][0][m][0][e] + ba0[e]); l1[e] = c81[e] * fsigmoid(acc[ai][0][m][1][e] + ba1[e]); }
            v4u lw; lw.x = cvt_pk_bf16(l0[0], l0[1]); lw.y = cvt_pk_bf16(l0[2], l0[3]); lw.z = cvt_pk_bf16(l1[0], l1[1]); lw.w = cvt_pk_bf16(l1[2], l1[3]);
            const f32x4 r0 = {bf_lo(lw.x), bf_hi(lw.x), bf_lo(lw.y), bf_hi(lw.y)}, r1 = {bf_lo(lw.z), bf_hi(lw.z), bf_lo(lw.w), bf_hi(lw.w)};
            f32x4 o0, o1;
#pragma unroll
            for (int e = 0; e < 4; ++e) { o0[e] = __builtin_amdgcn_sqrtf(one_minus_exp(2.0f * r0[e])) * fsigmoid(acc[ai][1][m][0][e] + bx0[e]) * x0[e];
                                          o1[e] = __builtin_amdgcn_sqrtf(one_minus_exp(2.0f * r1[e])) * fsigmoid(acc[ai][1][m][1][e] + bx1[e]) * x1[e]; }
            v4u ow; ow.x = cvt_pk_bf16(o0[0], o0[1]); ow.y = cvt_pk_bf16(o0[2], o0[3]); ow.z = cvt_pk_bf16(o1[0], o1[1]); ow.w = cvt_pk_bf16(o1[2], o1[3]);
            *(LAS v4u*)(TL + lofs + (ai * 128 + m * 16) * 256) = lw; *(LAS v4u*)(TL + 65536 + lofs + (ai * 128 + m * 16) * 256) = ow; }
        asm volatile("s_waitcnt lgkmcnt(0)" ::: "memory");
    }
};
struct EpiS5E {
    float* E;
    __device__ __forceinline__ void operator()(EPI_ARGS) const {
        const int row0 = u.pm * 256 + wr * 64 + fr, c0 = wc * 32 + 8 * fq;
        ROWLOOP { float* p = E + ((size_t)u.pn * NCHX + row0 + ai * 128 + m * 16) * 128 + c0; *(f32x4*)p = acc[ai][0][m][0]; *(f32x4*)(p + 4) = acc[ai][0][m][1]; }
    }
};
struct EpiS5EL {
    LAS float* EL;
    __device__ __forceinline__ void operator()(EPI_ARGS) const {
        asm volatile("s_waitcnt vmcnt(0)" ::: "memory"); __builtin_amdgcn_s_barrier();
        const int row0 = wr * 64 + fr, c0 = wc * 32 + 8 * fq;
        ROWLOOP { LAS float* p = EL + (row0 + ai * 128 + m * 16) * 128 + c0; *(LAS f32x4*)p = acc[ai][0][m][0]; *(LAS f32x4*)(p + 4) = acc[ai][0][m][1]; }
        asm volatile("s_waitcnt lgkmcnt(0)" ::: "memory");
    }
};
struct EpiS5Y {
    bf16* Z;
    __device__ __forceinline__ void operator()(EPI_ARGS) const {
        const int row0 = u.pm * 256 + wr * 64 + fr;
        ROWLOOP { const int j = row0 + ai * 128 + m * 16;
#pragma unroll
            for (int bj = 0; bj < 2; ++bj) { const int col = bj * 128 + wc * 32 + 8 * fq, t = col >> 4, cp = col & 15;
                const f32x4 v0 = acc[ai][bj][m][0], v1 = acc[ai][bj][m][1];
                v4u w; w.x = cvt_pk_bf16(gelu_tanh(v0[0]), gelu_tanh(v0[1])); w.y = cvt_pk_bf16(gelu_tanh(v0[2]), gelu_tanh(v0[3]));
                w.z = cvt_pk_bf16(gelu_tanh(v1[0]), gelu_tanh(v1[1])); w.w = cvt_pk_bf16(gelu_tanh(v1[2]), gelu_tanh(v1[3]));
                *(v4u*)(Z + (size_t)(j * 16 + t) * DS + u.pn * 16 + cp) = w; } }
    }
};
struct EpiGlu {
    const bf16* Z; const float* bias; const float* gain; bf16* AO; u64* ss;
    __device__ __forceinline__ void operator()(EPI_ARGS) const {
        const int row0 = u.pm * 256 + wr * 64 + fr;
        float sq[2][4];
        ROWLOOP sq[ai][m] = 0.f;
#pragma unroll
        for (int bj = 0; bj < 2; ++bj) { const int c0 = u.pn * 256 + bj * 128 + wc * 32 + 8 * fq;
            const f32x4 b0 = *(const f32x4*)(bias + c0), b1 = *(const f32x4*)(bias + c0 + 4), g0 = *(const f32x4*)(gain + c0), g1 = *(const f32x4*)(gain + c0 + 4);
            v4u zq[2][4];
            ROWLOOP zq[ai][m] = *(const v4u*)(Z + (size_t)(row0 + ai * 128 + m * 16) * DS + c0);
            ROWLOOP { const int row = row0 + ai * 128 + m * 16;
                const v4u zw = zq[ai][m];
                const f32x4 z0 = {bf_lo(zw.x), bf_hi(zw.x), bf_lo(zw.y), bf_hi(zw.y)}, z1 = {bf_lo(zw.z), bf_hi(zw.z), bf_lo(zw.w), bf_hi(zw.w)};
                f32x4 y0, y1;
#pragma unroll
                for (int e = 0; e < 4; ++e) { y0[e] = z0[e] * fsigmoid(acc[ai][bj][m][0][e] + b0[e]); y1[e] = z1[e] * fsigmoid(acc[ai][bj][m][1][e] + b1[e]); }
                sq[ai][m] += (y0[0] * y0[0] + y0[1] * y0[1]) + (y0[2] * y0[2] + y0[3] * y0[3]) + (y1[0] * y1[0] + y1[1] * y1[1]) + (y1[2] * y1[2] + y1[3] * y1[3]);
                const f32x4 w0 = y0 * g0, w1 = y1 * g1;
                v4u w; w.x = cvt_pk_bf16(w0[0], w0[1]); w.y = cvt_pk_bf16(w0[2], w0[3]); w.z = cvt_pk_bf16(w1[0], w1[1]); w.w = cvt_pk_bf16(w1[2], w1[3]);
                *(v4u*)(AO + (size_t)row * D + c0) = w; } }
        ROWLOOP { float s = sq[ai][m]; s += __shfl_xor(s, 16); s += __shfl_xor(s, 32);
            if (fq == 0) ss_add(ss + row0 + ai * 128 + m * 16, s); }
    }
};

struct Args { const float* in[33]; float* out; unsigned char* ws; int ph_lo, ph_hi; };
enum { I_X = 0, I_META, I_N1, I_WG1, I_WU1, I_WD1, I_NMIX, I_WIN, I_CONVW, I_CONVB, I_WA, I_BA, I_WX, I_BX, I_LAM, I_S5LRE, I_S5LIM, I_S5LDT, I_S5BRE, I_S5BIM, I_S5CRE, I_S5CIM,
       I_S5D, I_GLUW, I_GLUB, I_NRG, I_NS5, I_WOUT, I_N2, I_WG2, I_WU2, I_WD2, I_NFIN };

struct CvtJob { const float* W; int N; bf16* WT; int ldk, k0, n0, dest_row0; const float* gk; float wscale; };
__device__ __forceinline__ void cvt_load(const CvtJob& j, float (&v)[32], int lane) {
#pragma unroll
    for (int i = 0; i < 32; ++i) v[i] = j.W[(size_t)(j.k0 + 2 * i + (lane >> 5)) * j.N + j.n0 + (lane & 31)];
    if (j.gk) {
#pragma unroll
        for (int i = 0; i < 32; ++i) v[i] *= j.gk[2 * i + (lane >> 5)]; }
    if (j.wscale != 1.0f) {
#pragma unroll
        for (int i = 0; i < 32; ++i) v[i] *= j.wscale; }
}
__device__ __forceinline__ void cvt_to_lds(const float (&v)[32], LAS float* scr, int lane) {
#pragma unroll
    for (int i = 0; i < 32; ++i) scr[(2 * i + (lane >> 5)) * 33 + (lane & 31)] = v[i];
}
__device__ __forceinline__ void cvt_store(const CvtJob& j, LAS float* scr, int lane) {
    LDS_WAIT(); asm volatile("" ::: "memory");
    const int c = lane & 7;
#pragma unroll
    for (int q = 0; q < 4; ++q) { const int n = (lane >> 3) + 8 * q; const LAS float* s = scr + (8 * c) * 33 + n;
        v4u o; o.x = cvt_pk_bf16(s[0 * 33], s[1 * 33]); o.y = cvt_pk_bf16(s[2 * 33], s[3 * 33]); o.z = cvt_pk_bf16(s[4 * 33], s[5 * 33]); o.w = cvt_pk_bf16(s[6 * 33], s[7 * 33]);
        *(v4u*)(j.WT + (size_t)(j.dest_row0 + n) * j.ldk + j.k0 + 8 * c) = o; }
    LDS_WAIT(); asm volatile("" ::: "memory");
}
template <int MODE> __device__ __forceinline__ CvtJob cvt_job(const float* W, int K, int N, bf16* WT, int it, const float* gk, float wscale) {
    const int nblk = N / 32, kb = it / nblk, nb = it % nblk, k0 = kb * 64, n0 = nb * 32; const float* g = gk ? gk + k0 : nullptr;
    if (MODE == 3) return CvtJob{W + (size_t)k0 * N, N, WT + (k0 + K / 2) % K, K, 0, n0, n0, g, wscale};
    if (MODE == 0) return CvtJob{W, N, WT, K, k0, n0, n0, g, wscale};
    return CvtJob{W, N, WT, K, k0, n0, (n0 >> 7) * 256 + (MODE - 1) * 128 + (n0 & 127), g, wscale};
}
template <int MODE> __device__ __forceinline__ void cvt_matrix(const float* W, int K, int N, bf16* WT, LAS float* scr, int gw, int NGW, int lane, const float* gk = nullptr, float wscale = 1.0f) {
    const int nit = (K / 64) * (N / 32);
    int it = gw; if (it >= nit) return;
    float v[32]; CvtJob cur = cvt_job<MODE>(W, K, N, WT, it, gk, wscale); cvt_load(cur, v, lane);
    for (;;) {
        cvt_to_lds(v, scr, lane);
        const int nx = it + NGW; const bool more = nx < nit; CvtJob nxt = cur;
        if (more) { nxt = cvt_job<MODE>(W, K, N, WT, nx, gk, wscale); cvt_load(nxt, v, lane); }
        cvt_store(cur, scr, lane);
        if (!more) break;
        it = nx; cur = nxt;
    }
}
__device__ __forceinline__ void cvt_item(const float* W, int N, bf16* WT, int ldk, int k0, int n0, int dest_row0, LAS float* scr, int lane) {
    const CvtJob j{W, N, WT, ldk, k0, n0, dest_row0, nullptr, 1.0f}; float v[32]; cvt_load(j, v, lane); cvt_to_lds(v, scr, lane); cvt_store(j, scr, lane);
}

__device__ __forceinline__ int q127(float v) { return __float2int_rn(__builtin_amdgcn_fmed3f(v, -127.0f, 127.0f)); }
__device__ __forceinline__ unsigned pack_i8x4(float a, float b, float c, float d) {
    return ((unsigned)q127(a) & 255u) | (((unsigned)q127(b) & 255u) << 8) | (((unsigned)q127(c) & 255u) << 16) | ((unsigned)q127(d) << 24); }
__device__ __forceinline__ void colmax_matrix(const float* W, int K, int N, const float* gk, unsigned* cm, int gw, int NGW, int lane) {
    const int nblk = N / 256, nit = (K / 64) * nblk;
    for (int it = gw; it < nit; it += NGW) { const int kb = it / nblk, nb = it % nblk, n = nb * 256 + 4 * lane; f32x4 mx = {0.f, 0.f, 0.f, 0.f};
        for (int k0 = kb * 64; k0 < kb * 64 + 64; k0 += 16) { f32x4 v[16];
#pragma unroll
            for (int j = 0; j < 16; ++j) v[j] = *(const f32x4*)(W + (size_t)(k0 + j) * N + n);
#pragma unroll
            for (int j = 0; j < 16; ++j) { const float gg = gk ? gk[k0 + j] : 1.0f;
#pragma unroll
                for (int e = 0; e < 4; ++e) mx[e] = fmaxf(mx[e], fabsf(v[j][e] * gg)); } }
#pragma unroll
        for (int e = 0; e < 4; ++e) atomicMax(cm + n + e, __float_as_uint(mx[e])); }
}
__device__ __forceinline__ void quant_gu_matrix(const float* W, int K, int N, const float* gk, const unsigned* cm, unsigned char* WT, float* sw, int half_gu, LAS unsigned* scr, int gw, int NGW, int lane, float sscale = 1.0f, bool rev = false) {
    const int nblk = N / 32, nit = (K / 128) * nblk, hl = lane >> 5, nl = lane & 31;
    for (int it0 = gw; it0 < nit; it0 += NGW) { const int it = rev ? nit - 1 - it0 : it0;
        const int kb = it / nblk, nb = it % nblk, k0 = kb * 128, n0 = nb * 32, drow0 = (half_gu < 0) ? n0 : (n0 >> 7) * 256 + half_gu * 128 + (n0 & 127);
        const float cmx = __uint_as_float(cm[n0 + nl]), inv = cmx > 0.f ? 127.0f / cmx : 0.f;
        if (kb == 0 && hl == 0) sw[drow0 + nl] = cmx * (sscale / 127.0f);
        float v[16][4];
#pragma unroll
        for (int j = 0; j < 16; ++j)
#pragma unroll
            for (int e = 0; e < 4; ++e) v[j][e] = W[(size_t)(k0 + 8 * j + 4 * hl + e) * N + n0 + nl];
        if (gk) {
#pragma unroll
            for (int j = 0; j < 16; ++j)
#pragma unroll
                for (int e = 0; e < 4; ++e) v[j][e] *= gk[k0 + 8 * j + 4 * hl + e]; }
#pragma unroll
        for (int j = 0; j < 16; ++j) scr[nl * 33 + 2 * j + hl] = pack_i8x4(v[j][0] * inv, v[j][1] * inv, v[j][2] * inv, v[j][3] * inv);
        LDS_WAIT(); asm volatile("" ::: "memory");
#pragma unroll
        for (int q = 0; q < 4; ++q) { const int r = (lane >> 3) + 8 * q, pc = lane & 7; const LAS unsigned* sp = scr + r * 33 + 4 * pc;
            v4u o; o.x = sp[0]; o.y = sp[1]; o.z = sp[2]; o.w = sp[3];
            *(v4u*)(WT + (size_t)(drow0 + r) * K + k0 + 16 * pc) = o; }
        LDS_WAIT(); asm volatile("" ::: "memory"); }
}

struct Ctx { LAS unsigned char* lds; int wave, vcu, G; };
#define PHASE_IDS const int lane_ = pg8::lane_id_opaque(); const int tid_ = F.wave * 64 + lane_;

__device__ __forceinline__ void s5_tables(const Args& a, const Ctx& F, int g, int hv) {
    PHASE_IDS
    LAS f32x2* pw = (LAS f32x2*)(F.lds);
    LAS f32x2* bb = (LAS f32x2*)(F.lds + 8704);
    LAS f32x2* cc = (LAS f32x2*)(F.lds + 8704 + 8192);
    LAS float* Kt = (LAS float*)(F.lds + 8704 + 16384);
    LAS f32x2* qn = (LAS f32x2*)(F.lds + 8704 + 32768);
    const float dt = expf(a.in[I_S5LDT][g]);
    const float* lre = a.in[I_S5LRE] + g * 64; const float* lim = a.in[I_S5LIM] + g * 64;
    float* BBg = (float*)(a.ws + WS_S5BB); float* LAMg = (float*)(a.ws + WS_S5LAM);
    if (tid_ < 64) { const int n = tid_; const float x = lre[n] * dt, th = lim[n] * dt, mag = expf(x), e1 = expm1f(x); float sn, co; sincosf(th, &sn, &co); const float sh = sinf(0.5f * th);
        const float lr = mag * co, li = mag * sn; float pr = 1.f, pi = 0.f;
#pragma unroll
        for (int tau = 0; tau <= 16; ++tau) { pw[tau * 64 + n] = (f32x2){pr, pi}; if (tau == 1 && hv == 0) { LAMg[(size_t)(g * 64 + n) * 4] = pr; LAMg[(size_t)(g * 64 + n) * 4 + 1] = pi; }
            if (tau == 16 && hv == 0) { LAMg[(size_t)(g * 64 + n) * 4 + 2] = pr; LAMg[(size_t)(g * 64 + n) * 4 + 3] = pi; }
            const float nr = pr * lr - pi * li, ni = pr * li + pi * lr; pr = nr; pi = ni; }
        const float nr = e1 * co - 2.0f * sh * sh, ni = (e1 + 1.0f) * sn;
        const float ar = lre[n], ai = lim[n], den = 1.0f / (ar * ar + ai * ai);
        qn[n] = (f32x2){(nr * ar + ni * ai) * den, (ni * ar - nr * ai) * den}; }
    for (int idx = tid_; idx < 16 * 64; idx += NTHR) { const int c = idx >> 6, n = idx & 63; cc[idx] = (f32x2){a.in[I_S5CRE][(g * 16 + c) * 64 + n], a.in[I_S5CIM][(g * 16 + c) * 64 + n]}; }
    __syncthreads();
    for (int idx = tid_; idx < 64 * 16; idx += NTHR) { const int n = idx >> 4, c = idx & 15; const f32x2 q = qn[n];
        const float br = a.in[I_S5BRE][(g * 64 + n) * 16 + c], bi = a.in[I_S5BIM][(g * 64 + n) * 16 + c];
        const f32x2 v = {q.x * br - q.y * bi, q.x * bi + q.y * br};
        bb[idx] = v; if (hv == 0) *(f32x2*)(BBg + ((size_t)(g * 64 + n) * 16 + c) * 2) = v; }
    __syncthreads();
    { const int tau = tid_ >> 5, c = 8 * hv + ((tid_ >> 2) & 7), cq = tid_ & 3; float k4[4] = {0.f, 0.f, 0.f, 0.f};
        for (int n = 0; n < 64; ++n) { const f32x2 C = cc[c * 64 + n], P = pw[tau * 64 + n]; const float qr = C.x * P.x - C.y * P.y, qi = C.x * P.y + C.y * P.x;
#pragma unroll
            for (int e = 0; e < 4; ++e) { const f32x2 B = bb[n * 16 + 4 * cq + e]; k4[e] += qr * B.x - qi * B.y; } }
#pragma unroll
        for (int e = 0; e < 4; ++e) { if (tau == 0 && c == 4 * cq + e) k4[e] += a.in[I_S5D][g * 16 + c]; Kt[(tau * 16 + c) * 16 + 4 * cq + e] = k4[e]; } }
    __syncthreads();
    bf16* TQ = (bf16*)(a.ws + WS_S5TQ) + (size_t)g * 256 * UK; bf16* PP = (bf16*)(a.ws + WS_S5P) + (size_t)g * 256 * 256;
    for (int idx = tid_; idx < 128 * 48; idx += NTHR) { const int rr = idx / 48, kc = idx % 48, t = rr >> 3, c = 8 * hv + (rr & 7), rho = t * 16 + c; float v[8];
        if (kc < 32) { const int sx = kc >> 1, cp0 = (kc & 1) * 8;
#pragma unroll
            for (int e = 0; e < 8; ++e) v[e] = (t >= sx) ? Kt[((t - sx) * 16 + c) * 16 + cp0 + e] : 0.f; }
        else { const int n0 = (kc - 32) * 4;
#pragma unroll
            for (int e = 0; e < 4; ++e) { const f32x2 C = cc[c * 64 + n0 + e], P = pw[(t + 1) * 64 + n0 + e]; v[2 * e] = C.x * P.x - C.y * P.y; v[2 * e + 1] = -(C.x * P.y + C.y * P.x); } }
        v4u w; w.x = cvt_pk_bf16(v[0], v[1]); w.y = cvt_pk_bf16(v[2], v[3]); w.z = cvt_pk_bf16(v[4], v[5]); w.w = cvt_pk_bf16(v[6], v[7]);
        *(v4u*)(TQ + (size_t)rho * UK + kc * 8) = w; }
    for (int idx = tid_; idx < 128 * 32; idx += NTHR) { const int rr = idx >> 5, kc = idx & 31, sx = kc >> 1, cp0 = (kc & 1) * 8; float v[8];
#pragma unroll
        for (int e = 0; e < 8; ++e) v[e] = 0.f;
        const int rho = (rr < 64) ? 64 * hv + rr : 128 + 64 * hv + (rr - 64);
        if (rr < 64) { const int n = rho >> 1; const f32x2 P = pw[(15 - sx) * 64 + n];
#pragma unroll
            for (int e = 0; e < 8; ++e) { const f32x2 B = bb[n * 16 + cp0 + e]; v[e] = (rho & 1) ? (P.x * B.y + P.y * B.x) : (P.x * B.x - P.y * B.y); } }
        v4u w; w.x = cvt_pk_bf16(v[0], v[1]); w.y = cvt_pk_bf16(v[2], v[3]); w.z = cvt_pk_bf16(v[4], v[5]); w.w = cvt_pk_bf16(v[6], v[7]);
        *(v4u*)(PP + (size_t)rho * 256 + kc * 8) = w; }
    __syncthreads();
}

__device__ __forceinline__ void p0_prologue(const Args& a, const Ctx& F) {
    PHASE_IDS
    if (PROBE_SPIN == 21 && blockIdx.x == 0 && threadIdx.x == 0) ((unsigned long long*)((unsigned*)(a.ws + WS_CTL) + 3000))[21] = wall_clock64();
    for (int j = F.vcu; j < 2 * NG; j += F.G) s5_tables(a, F, j & (NG - 1), j >> 7);
    if (PROBE_SPIN == 21 && blockIdx.x == 0 && threadIdx.x == 0) ((unsigned long long*)((unsigned*)(a.ws + WS_CTL) + 3000))[22] = wall_clock64();
    LAS float* scr = (LAS float*)(F.lds + F.wave * 16384);
    const int gw = F.vcu * NWAVES + F.wave, NGW = F.G * NWAVES;
    cvt_matrix<0>(a.in[I_WD1], FF, D, (bf16*)(a.ws + WS_W1D), scr, gw, NGW, lane_, nullptr, 0.5f);
    cvt_matrix<0>(a.in[I_WIN], D, 6144, (bf16*)(a.ws + WS_WIN), scr, gw, NGW, lane_, a.in[I_NMIX], 1.0f);
    cvt_matrix<0>(a.in[I_GLUW], DS, DS, (bf16*)(a.ws + WS_WGLU), scr, gw, NGW, lane_);
    cvt_matrix<3>(a.in[I_WOUT], D, D, (bf16*)(a.ws + WS_WOUT), scr, gw, NGW, lane_);
    for (int it = gw; it < 512; it += NGW) { const int h = it >> 6, which = (it >> 5) & 1, kb = (it >> 3) & 3, nb = it & 7, n0 = nb * 32;
        cvt_item(a.in[which ? I_WX : I_WA] + (size_t)h * 65536, 256, (bf16*)(a.ws + WS_WRG), 256, kb * 64, n0, (h * 2 + (n0 >> 7)) * 256 + which * 128 + (n0 & 127), scr, lane_); }
    for (int i = F.vcu * NTHR + tid_; i < DR; i += F.G * NTHR) ((float*)(a.ws + WS_C8))[i] = -8.0f * log1pf(expf(-a.in[I_LAM][i]));
    unsigned char* A1 = (unsigned char*)(a.ws + WS_AX); float* SA1 = (float*)(a.ws + WS_SW + 131072); float* H0M = (float*)(a.ws + WS_H0M); const float* g1 = a.in[I_N1];
    for (int m = gw; m < MP; m += NGW) {
        f32x4 v[16];
        if (m < MX + 16) { const float* src = (m < MX) ? a.in[I_X] + (size_t)m * D : a.in[I_META] + (size_t)(m - MX) * D;
#pragma unroll
            for (int j = 0; j < 16; ++j) v[j] = *(const f32x4*)(src + 4 * lane_ + 256 * j); }
        else {
#pragma unroll
            for (int j = 0; j < 16; ++j) v[j] = (f32x4){0.f, 0.f, 0.f, 0.f}; }
        if (m >= MX) {
#pragma unroll
            for (int j = 0; j < 16; ++j) *(f32x4*)(H0M + (size_t)(m - MX) * D + 4 * lane_ + 256 * j) = v[j]; }
        float s = 0.f;
#pragma unroll
        for (int j = 0; j < 16; ++j) s += (v[j][0] * v[j][0] + v[j][1] * v[j][1]) + (v[j][2] * v[j][2] + v[j][3] * v[j][3]);
        const float rs = __builtin_amdgcn_rsqf(wave_sum(s) * (1.0f / D) + EPS);
        float mx = 0.f;
#pragma unroll
        for (int j = 0; j < 16; ++j) { v[j] = v[j] * rs * *(const f32x4*)(g1 + 4 * lane_ + 256 * j);
            mx = fmaxf(fmaxf(mx, fmaxf(fabsf(v[j][0]), fabsf(v[j][1]))), fmaxf(fabsf(v[j][2]), fabsf(v[j][3]))); }
#pragma unroll
        for (int o = 1; o < 64; o <<= 1) mx = fmaxf(mx, __shfl_xor(mx, o));
        const float inv = mx > 0.f ? 127.0f / mx : 0.f;
        if (lane_ == 0) SA1[m] = mx * (1.0f / 127.0f);
#pragma unroll
        for (int j = 0; j < 16; ++j) *(unsigned*)(A1 + (size_t)m * D + 4 * lane_ + 256 * j) = pack_i8x4(v[j][0] * inv, v[j][1] * inv, v[j][2] * inv, v[j][3] * inv);
    }
    colmax_matrix(a.in[I_WG1], D, FF, nullptr, (unsigned*)(a.ws + WS_CTL) + CW_CM, gw, NGW, lane_);
    colmax_matrix(a.in[I_WU1], D, FF, nullptr, (unsigned*)(a.ws + WS_CTL) + CW_CM + FF, gw, NGW, lane_);
}

__device__ __forceinline__ void p8_quant_w2(const Args& a, const Ctx& F) {
    PHASE_IDS
    LAS unsigned* scr = (LAS unsigned*)(F.lds + F.wave * 8192);
    const int gw = F.vcu * NWAVES + F.wave, NGW = F.G * NWAVES; const unsigned* cm = (const unsigned*)(a.ws + WS_CTL) + CW_CM + 2 * FF;
    quant_gu_matrix(a.in[I_WU2], D, FF, a.in[I_N2], cm + FF, (unsigned char*)(a.ws + WS_W1GU), (float*)(a.ws + WS_SW), 1, scr, gw, NGW, lane_, 1.0f, true);
    quant_gu_matrix(a.in[I_WG2], D, FF, a.in[I_N2], cm, (unsigned char*)(a.ws + WS_W1GU), (float*)(a.ws + WS_SW), 0, scr, gw, NGW, lane_, 1.0f, true);
    __syncthreads();
}
__device__ __forceinline__ void p11_quant_wd(const Args& a, const Ctx& F, int wi, int nw) {
    PHASE_IDS
    LAS unsigned* scr = (LAS unsigned*)(F.lds + F.wave * 8192);
    quant_gu_matrix(a.in[I_WD2], FF, D, nullptr, (const unsigned*)(a.ws + WS_CTL) + CW_CMD, (unsigned char*)(a.ws + WS_W1D), (float*)(a.ws + WS_SW + 262144), -1, scr, wi * NWAVES + F.wave, nw * NWAVES, lane_, 0.5f);
}
__device__ __forceinline__ void p10_quant_h2(const Args& a, const Ctx& F) {
    PHASE_IDS
    const bf16* HB = (const bf16*)(a.ws + WS_HB); unsigned char* A2 = (unsigned char*)(a.ws + WS_AX); float* SA2 = (float*)(a.ws + WS_SW + 131072);
    const u64* ss2 = (const u64*)((const unsigned*)(a.ws + WS_CTL) + CW_SS) + MP;
    const int gw = F.vcu * NWAVES + F.wave, NGW = F.G * NWAVES;
    for (int m = gw; m < MX; m += NGW) { v4u w[8]; float mx = 0.f;
#pragma unroll
        for (int j = 0; j < 8; ++j) w[j] = *(const v4u*)(HB + (size_t)m * D + 8 * lane_ + 512 * j);
#pragma unroll
        for (int j = 0; j < 8; ++j) { mx = fmaxf(fmaxf(mx, fmaxf(fabsf(bf_lo(w[j].x)), fabsf(bf_hi(w[j].x)))), fmaxf(fabsf(bf_lo(w[j].y)), fabsf(bf_hi(w[j].y))));
                                      mx = fmaxf(fmaxf(mx, fmaxf(fabsf(bf_lo(w[j].z)), fabsf(bf_hi(w[j].z)))), fmaxf(fabsf(bf_lo(w[j].w)), fabsf(bf_hi(w[j].w)))); }
#pragma unroll
        for (int o = 1; o < 64; o <<= 1) mx = fmaxf(mx, __shfl_xor(mx, o));
        const float inv = mx > 0.f ? 127.0f / mx : 0.f;
        if (lane_ == 0) SA2[m] = mx * (1.0f / 127.0f) * __builtin_amdgcn_rsqf(ss_get(ss2 + m) * (1.0f / D) + EPS);
#pragma unroll
        for (int j = 0; j < 8; ++j) { v2u q; q.x = pack_i8x4(bf_lo(w[j].x) * inv, bf_hi(w[j].x) * inv, bf_lo(w[j].y) * inv, bf_hi(w[j].y) * inv);
            q.y = pack_i8x4(bf_lo(w[j].z) * inv, bf_hi(w[j].z) * inv, bf_lo(w[j].w) * inv, bf_hi(w[j].w) * inv); *(v2u*)(A2 + (size_t)m * D + 8 * lane_ + 512 * j) = q; } }
}

__device__ __forceinline__ void p12_quant_h(const Args& a, const Ctx& F) {
    PHASE_IDS
    const bf16* H = (const bf16*)(a.ws + WS_H); unsigned char* Hq = (unsigned char*)(a.ws + WS_AX); float* SH = (float*)(a.ws + WS_SW + 393216);
    LAS float* xm = (LAS float*)F.lds;
    const int pair = F.wave >> 1, hf = F.wave & 1, NP = F.G * 4;
    int it = 0;
    for (int m0 = F.vcu * 4 + pair; m0 < MX; m0 += NP, ++it) {
        const int m = MX - 1 - m0;
        v4u w[11]; float mx = 0.f;
#pragma unroll
        for (int j = 0; j < 11; ++j) { const int ch = lane_ + 64 * (j + 11 * hf); w[j] = (ch < FF / 8) ? *(const v4u*)(H + (size_t)m * FF + 8 * ch) : (v4u){0u, 0u, 0u, 0u}; }
#pragma unroll
        for (int j = 0; j < 11; ++j) { mx = fmaxf(fmaxf(mx, fmaxf(fabsf(bf_lo(w[j].x)), fabsf(bf_hi(w[j].x)))), fmaxf(fabsf(bf_lo(w[j].y)), fabsf(bf_hi(w[j].y))));
                                       mx = fmaxf(fmaxf(mx, fmaxf(fabsf(bf_lo(w[j].z)), fabsf(bf_hi(w[j].z)))), fmaxf(fabsf(bf_lo(w[j].w)), fabsf(bf_hi(w[j].w)))); }
#pragma unroll
        for (int o = 1; o < 64; o <<= 1) mx = fmaxf(mx, __shfl_xor(mx, o));
        if (lane_ == 0) xm[(it & 1) * 8 + F.wave] = mx;
        __syncthreads();
        mx = fmaxf(mx, xm[(it & 1) * 8 + (F.wave ^ 1)]);
        const float inv = mx > 0.f ? 127.0f / mx : 0.f;
        if (lane_ == 0 && hf == 0) SH[m] = mx * (1.0f / 127.0f);
#pragma unroll
        for (int j = 0; j < 11; ++j) { const int ch = lane_ + 64 * (j + 11 * hf);
            if (ch < FF / 8) { v2u q; q.x = pack_i8x4(bf_lo(w[j].x) * inv, bf_hi(w[j].x) * inv, bf_lo(w[j].y) * inv, bf_hi(w[j].y) * inv);
                q.y = pack_i8x4(bf_lo(w[j].z) * inv, bf_hi(w[j].z) * inv, bf_lo(w[j].w) * inv, bf_hi(w[j].w) * inv); *(v2u*)(Hq + (size_t)m * FF + 8 * ch) = q; } } }
    __syncthreads();
}

__device__ __forceinline__ void p1_quant_w1(const Args& a, const Ctx& F) {
    PHASE_IDS
    LAS unsigned* scr = (LAS unsigned*)(F.lds + F.wave * 8192);
    const int gw = F.vcu * NWAVES + F.wave, NGW = F.G * NWAVES; const unsigned* cm = (const unsigned*)(a.ws + WS_CTL) + CW_CM;
    quant_gu_matrix(a.in[I_WU1], D, FF, nullptr, cm + FF, (unsigned char*)(a.ws + WS_W1GU), (float*)(a.ws + WS_SW), 1, scr, gw, NGW, lane_, 1.0f, true);
    quant_gu_matrix(a.in[I_WG1], D, FF, nullptr, cm, (unsigned char*)(a.ws + WS_W1GU), (float*)(a.ws + WS_SW), 0, scr, gw, NGW, lane_, 1.0f, true);
}

__device__ __forceinline__ void p4_conv(const Args& a, const Ctx& F) {
    PHASE_IDS
    const bf16* ur = (const bf16*)((const char*)a.out + DO_URG); bf16* xcb = (bf16*)(a.ws + WS_XCB);
    const float* cw = a.in[I_CONVW]; const float* cb = a.in[I_CONVB];
    for (int idx = F.vcu * NTHR + tid_; idx < (MP / 8) * 256; idx += F.G * NTHR) { const int row0 = (idx >> 8) * 8, c8 = (idx & 255) * 8;
        v4u raw[11];
#pragma unroll
        for (int j = 0; j < 11; ++j) { const int r = row0 - 3 + j; int srow;
            if (row0 < MX) srow = (j >= 3) ? r : (((row0 & 4095) != 0) ? r : MX + 13 + j);
            else srow = (j >= 3 || row0 > MX) ? r : -1;
            if (srow >= 0) raw[j] = *(const v4u*)(ur + (size_t)srow * DR + c8); else raw[j] = (v4u){0u, 0u, 0u, 0u}; }
        v4u outw[8];
#pragma unroll
        for (int hh = 0; hh < 2; ++hh) { const int c4 = c8 + 4 * hh;
            const f32x4 bias = *(const f32x4*)(cb + c4), w0 = *(const f32x4*)(cw + c4), w1 = *(const f32x4*)(cw + DR + c4), w2 = *(const f32x4*)(cw + 2 * DR + c4), w3 = *(const f32x4*)(cw + 3 * DR + c4);
            f32x4 uu[11];
#pragma unroll
            for (int j = 0; j < 11; ++j) { const unsigned lo = hh ? raw[j].z : raw[j].x, hi = hh ? raw[j].w : raw[j].y; uu[j] = (f32x4){bf_lo(lo), bf_hi(lo), bf_lo(hi), bf_hi(hi)}; }
#pragma unroll
            for (int j = 0; j < 8; ++j) { const f32x4 sv = bias + w0 * uu[j] + w1 * uu[j + 1] + w2 * uu[j + 2] + w3 * uu[j + 3];
                const unsigned p0 = cvt_pk_bf16(sv[0], sv[1]), p1 = cvt_pk_bf16(sv[2], sv[3]);
                if (hh) { outw[j].z = p0; outw[j].w = p1; } else { outw[j].x = p0; outw[j].y = p1; } } }
#pragma unroll
        for (int j = 0; j < 8; ++j) *(v4u*)(xcb + (size_t)(row0 + j) * DR + c8) = outw[j]; }
}
__device__ __forceinline__ void p7_colmax_w2(const Args& a, const Ctx& F) {
    PHASE_IDS
    const int gw = F.vcu * NWAVES + F.wave, NGW = F.G * NWAVES;
    colmax_matrix(a.in[I_WD2], FF, D, nullptr, (unsigned*)(a.ws + WS_CTL) + CW_CMD, gw, NGW, lane_);
    colmax_matrix(a.in[I_WG2], D, FF, a.in[I_N2], (unsigned*)(a.ws + WS_CTL) + CW_CM + 2 * FF, gw, NGW, lane_);
    colmax_matrix(a.in[I_WU2], D, FF, a.in[I_N2], (unsigned*)(a.ws + WS_CTL) + CW_CM + 3 * FF, gw, NGW, lane_);
}

__device__ __forceinline__ void rg_scan_lds(const Args& a, const LAS unsigned char* TL, int pm, int pn, int tid) {
    if (tid < 256) { const int sg = tid >> 7, cl = tid & 127, ch = (pn >> 1) * 256 + (pn & 1) * 128 + cl, row_base = pm * 256 + sg * 128, b = row_base >> 12, seg = (row_base & 4095) >> 7;
        unsigned short* LA = (unsigned short*)((char*)a.out + DO_UA); unsigned short* BX = (unsigned short*)(a.ws + WS_AX);
        float* segP = (float*)(a.ws + WS_SEG); float* segH = segP + 4 * NSEG * DR;
        const LAS unsigned short* lp = (const LAS unsigned short*)TL + (sg * 128) * 128 + cl; const LAS unsigned short* xp = lp + 32768;
        float h = 0.f, P = 1.f;
#pragma unroll 8
        for (int k = 0; k < 128; ++k) { const float l = __uint_as_float((unsigned)lp[k * 128] << 16), x = __uint_as_float((unsigned)xp[k * 128] << 16);
            const float av = __builtin_amdgcn_exp2f(1.4426950408889634f * l); h = av * h + x; P *= av;
            const unsigned hp = cvt_pk_bf16(h, P); const size_t o = (size_t)(row_base + k) * DR + ch;
            BX[o] = (unsigned short)(hp & 0xffffu); LA[o] = (unsigned short)(hp >> 16); }
        segP[(size_t)(b * NSEG + seg) * DR + ch] = P; segH[(size_t)(b * NSEG + seg) * DR + ch] = h; }
    __syncthreads();
}

__device__ __forceinline__ void p6_scans(const Args& a, const Ctx& F) {
    PHASE_IDS
    unsigned* LA = (unsigned*)(a.out + DO_UA / 4); unsigned* BX = (unsigned*)(a.ws + WS_AX);
    float* segP = (float*)(a.ws + WS_SEG); float* segH = segP + 4 * NSEG * DR;
    for (int w = F.vcu; w < 256; w += F.G) { const int b = w >> 6, seg = (w >> 1) & 31, cp = (w & 1) * 512 + tid_;
        const size_t base = ((size_t)b * 4096 + seg * SEGL) * (DR / 2) + cp;
        float h0 = 0.f, h1 = 0.f, P0 = 1.f, P1 = 1.f;
        for (int t0 = 0; t0 < SEGL; t0 += 16) { unsigned lv[16], xv[16];
#pragma unroll
            for (int j = 0; j < 16; ++j) { lv[j] = LA[base + (size_t)(t0 + j) * (DR / 2)]; xv[j] = BX[base + (size_t)(t0 + j) * (DR / 2)]; }
#pragma unroll
            for (int j = 0; j < 16; ++j) { const float a0 = __builtin_amdgcn_exp2f(1.4426950408889634f * bf_lo(lv[j])), a1 = __builtin_amdgcn_exp2f(1.4426950408889634f * bf_hi(lv[j]));
                h0 = a0 * h0 + bf_lo(xv[j]); h1 = a1 * h1 + bf_hi(xv[j]); P0 *= a0; P1 *= a1;
                BX[base + (size_t)(t0 + j) * (DR / 2)] = cvt_pk_bf16(h0, h1); LA[base + (size_t)(t0 + j) * (DR / 2)] = cvt_pk_bf16(P0, P1); } }
        *(f32x2*)(segP + (size_t)(b * NSEG + seg) * DR + 2 * cp) = (f32x2){P0, P1}; *(f32x2*)(segH + (size_t)(b * NSEG + seg) * DR + 2 * cp) = (f32x2){h0, h1}; }
}

__device__ __forceinline__ void s5_carry_unit(const Args& a, int b, int g, int n) {
    bf16* U = (bf16*)(a.ws + WS_U); const float* E = a.out + DO_E / 4; const float* BBg = (const float*)(a.ws + WS_S5BB); const float* LAMg = (const float*)(a.ws + WS_S5LAM);
    const f32x4 lm = *(const f32x4*)(LAMg + (size_t)(g * 64 + n) * 4);
    f32x4 bq[8];
#pragma unroll
    for (int j = 0; j < 8; ++j) bq[j] = *(const f32x4*)(BBg + (size_t)(g * 64 + n) * 32 + 4 * j);
    float sr = 0.f, si = 0.f;
    const bf16* um = U + ((size_t)g * NCHP + NCHX) * UK;
    for (int s0 = 0; s0 < 16; s0 += 4) { v4u w0[4], w1[4];
#pragma unroll
        for (int q = 0; q < 4; ++q) { w0[q] = *(const v4u*)(um + (s0 + q) * 16); w1[q] = *(const v4u*)(um + (s0 + q) * 16 + 8); }
#pragma unroll
        for (int q = 0; q < 4; ++q) {
            const float uu[16] = {bf_lo(w0[q].x), bf_hi(w0[q].x), bf_lo(w0[q].y), bf_hi(w0[q].y), bf_lo(w0[q].z), bf_hi(w0[q].z), bf_lo(w0[q].w), bf_hi(w0[q].w),
                                  bf_lo(w1[q].x), bf_hi(w1[q].x), bf_lo(w1[q].y), bf_hi(w1[q].y), bf_lo(w1[q].z), bf_hi(w1[q].z), bf_lo(w1[q].w), bf_hi(w1[q].w)};
            float br = 0.f, bi = 0.f;
#pragma unroll
            for (int j = 0; j < 8; ++j) { br += bq[j][0] * uu[2 * j] + bq[j][2] * uu[2 * j + 1]; bi += bq[j][1] * uu[2 * j] + bq[j][3] * uu[2 * j + 1]; }
            const float nr = lm[0] * sr - lm[1] * si + br, ni = lm[0] * si + lm[1] * sr + bi; sr = nr; si = ni; } }
    bf16* up = U + ((size_t)g * NCHP + b * 256) * UK + 256 + 2 * n; const float* ep = E + ((size_t)g * NCHX + b * 256) * 128 + 2 * n;
    for (int k0 = 0; k0 < 256; k0 += 16) { f32x2 ev[16];
#pragma unroll
        for (int j = 0; j < 16; ++j) ev[j] = *(const f32x2*)(ep + (size_t)(k0 + j) * 128);
#pragma unroll
        for (int j = 0; j < 16; ++j) { *(unsigned*)(up + (size_t)(k0 + j) * UK) = cvt_pk_bf16(sr, si);
            const float nr = lm[2] * sr - lm[3] * si + ev[j].x, ni = lm[2] * si + lm[3] * sr + ev[j].y; sr = nr; si = ni; } }
}

__device__ __forceinline__ void s5_carry_lds(const Args& a, int b, int g, int n, int q, const LAS float* EL, LAS f32x2* xs) {
    bf16* U = (bf16*)(a.ws + WS_U); const float* BBg = (const float*)(a.ws + WS_S5BB); const float* LAMg = (const float*)(a.ws + WS_S5LAM);
    const f32x4 lm = *(const f32x4*)(LAMg + (size_t)(g * 64 + n) * 4);
    bf16* up = U + ((size_t)g * NCHP + b * 256 + 32 * q) * UK + 256 + 2 * n; const LAS f32x2* ep = (const LAS f32x2*)(EL + (32 * q) * 128 + 2 * n);
    float sr = 0.f, si = 0.f;
    if (q == 0) {
        f32x4 bq[8];
#pragma unroll
        for (int j = 0; j < 8; ++j) bq[j] = *(const f32x4*)(BBg + (size_t)(g * 64 + n) * 32 + 4 * j);
        const bf16* um = U + ((size_t)g * NCHP + NCHX) * UK;
        for (int s0 = 0; s0 < 16; s0 += 4) { v4u w0[4], w1[4];
#pragma unroll
            for (int p = 0; p < 4; ++p) { w0[p] = *(const v4u*)(um + (s0 + p) * 16); w1[p] = *(const v4u*)(um + (s0 + p) * 16 + 8); }
#pragma unroll
            for (int p = 0; p < 4; ++p) {
                const float uu[16] = {bf_lo(w0[p].x), bf_hi(w0[p].x), bf_lo(w0[p].y), bf_hi(w0[p].y), bf_lo(w0[p].z), bf_hi(w0[p].z), bf_lo(w0[p].w), bf_hi(w0[p].w),
                                      bf_lo(w1[p].x), bf_hi(w1[p].x), bf_lo(w1[p].y), bf_hi(w1[p].y), bf_lo(w1[p].z), bf_hi(w1[p].z), bf_lo(w1[p].w), bf_hi(w1[p].w)};
                float br = 0.f, bi = 0.f;
#pragma unroll
                for (int j = 0; j < 8; ++j) { br += bq[j][0] * uu[2 * j] + bq[j][2] * uu[2 * j + 1]; bi += bq[j][1] * uu[2 * j] + bq[j][3] * uu[2 * j + 1]; }
                const float nr = lm[0] * sr - lm[1] * si + br, ni = lm[0] * si + lm[1] * sr + bi; sr = nr; si = ni; } }
#pragma unroll 8
        for (int k = 0; k < 32; ++k) { const f32x2 ev = ep[k * 64]; *(unsigned*)(up + (size_t)k * UK) = cvt_pk_bf16(sr, si);
            const float nr = lm[2] * sr - lm[3] * si + ev.x, ni = lm[2] * si + lm[3] * sr + ev.y; sr = nr; si = ni; }
    } else {
#pragma unroll 8
        for (int k = 0; k < 32; ++k) { const f32x2 ev = ep[k * 64]; const float nr = lm[2] * sr - lm[3] * si + ev.x, ni = lm[2] * si + lm[3] * sr + ev.y; sr = nr; si = ni; }
    }
    xs[q * 64 + n] = (f32x2){sr, si};
    __syncthreads();
    if (q > 0) {
        float pr = lm[2], pi = lm[3];
#pragma unroll
        for (int t = 0; t < 5; ++t) { const float nr = pr * pr - pi * pi, ni = 2.0f * pr * pi; pr = nr; pi = ni; }
        f32x2 sv = xs[n];
        for (int t = 1; t < q; ++t) { const f32x2 T = xs[t * 64 + n]; const float nr = pr * sv.x - pi * sv.y + T.x, ni = pr * sv.y + pi * sv.x + T.y; sv.x = nr; sv.y = ni; }
        sr = sv.x; si = sv.y;
#pragma unroll 8
        for (int k = 0; k < 32; ++k) { const f32x2 ev = ep[k * 64]; *(unsigned*)(up + (size_t)k * UK) = cvt_pk_bf16(sr, si);
            const float nr = lm[2] * sr - lm[3] * si + ev.x, ni = lm[2] * si + lm[3] * sr + ev.y; sr = nr; si = ni; }
    }
    __syncthreads();
}

__device__ __forceinline__ void p7_rgfix(const Args& a, const Ctx& F) {
    PHASE_IDS
    const bf16* PA = (const bf16*)(a.out + DO_UA / 4); const bf16* HL = (const bf16*)(a.ws + WS_AX); const bf16* GG = (const bf16*)(a.ws + WS_GG);
    const float* segP = (const float*)(a.ws + WS_SEG); const float* segH = segP + 4 * NSEG * DR; const float* gn = a.in[I_NRG];
    bf16* AO = (bf16*)(a.ws + WS_AX2);
    LAS f32x4* carry = (LAS f32x4*)(F.lds);
    for (int w = F.vcu; w < 256; w += F.G) { const int b = w >> 6, seg = (w >> 1) & 31, q = w & 1;
        { const int c4 = tid_ * 4; f32x4 h = {0.f, 0.f, 0.f, 0.f};
            for (int r0 = 0; r0 < 16; r0 += 8) { v2u pa[8], pb[8];
#pragma unroll
                for (int j = 0; j < 8; ++j) { pa[j] = *(const v2u*)(PA + (size_t)(MX + r0 + j) * DR + c4); pb[j] = *(const v2u*)(HL + (size_t)(MX + r0 + j) * DR + c4); }
#pragma unroll
                for (int j = 0; j < 8; ++j) { const f32x4 la = {bf_lo(pa[j].x), bf_hi(pa[j].x), bf_lo(pa[j].y), bf_hi(pa[j].y)}, bx = {bf_lo(pb[j].x), bf_hi(pb[j].x), bf_lo(pb[j].y), bf_hi(pb[j].y)};
                    f32x4 av;
#pragma unroll
                    for (int e = 0; e < 4; ++e) av[e] = __builtin_amdgcn_exp2f(1.4426950408889634f * la[e]);
                    h = av * h + bx; } }
            for (int s0 = 0; s0 < seg; s0 += 8) { f32x4 pa[8], pb[8];
#pragma unroll
                for (int j = 0; j < 8; ++j) { const bool ok = s0 + j < seg; const size_t o = (size_t)(b * NSEG + (ok ? s0 + j : 0)) * DR + c4;
                    pa[j] = *(const f32x4*)(segP + o); pb[j] = *(const f32x4*)(segH + o); if (!ok) { pa[j] = (f32x4){1.f, 1.f, 1.f, 1.f}; pb[j] = (f32x4){0.f, 0.f, 0.f, 0.f}; } }
#pragma unroll
                for (int j = 0; j < 8; ++j) h = pa[j] * h + pb[j]; }
            carry[tid_] = h; }
        __syncthreads();
        const int rowb = b * 4096 + seg * SEGL + q * 64 + F.wave * 8;
        v4u hwn[4], pwn[4], gwn[4];
#pragma unroll
        for (int j = 0; j < 4; ++j) { const size_t off = (size_t)rowb * DR + 8 * lane_ + 512 * j; hwn[j] = *(const v4u*)(HL + off); pwn[j] = *(const v4u*)(PA + off); gwn[j] = *(const v4u*)(GG + off); }
#pragma unroll
        for (int rr = 0; rr < 8; ++rr) { const int row = rowb + rr;
            float y[4][8]; float s = 0.f;
            v4u hwc[4], pwc[4], gwc[4];
#pragma unroll
            for (int j = 0; j < 4; ++j) { hwc[j] = hwn[j]; pwc[j] = pwn[j]; gwc[j] = gwn[j]; }
            if (rr < 7) {
#pragma unroll
                for (int j = 0; j < 4; ++j) { const size_t off = (size_t)(row + 1) * DR + 8 * lane_ + 512 * j; hwn[j] = *(const v4u*)(HL + off); pwn[j] = *(const v4u*)(PA + off); gwn[j] = *(const v4u*)(GG + off); } }
#pragma unroll
            for (int j = 0; j < 4; ++j) {
                const v4u hw = hwc[j], pw = pwc[j], gw = gwc[j]; const f32x4 c0 = carry[2 * lane_ + 128 * j], c1 = carry[2 * lane_ + 128 * j + 1];
                const float hh[8] = {bf_lo(hw.x), bf_hi(hw.x), bf_lo(hw.y), bf_hi(hw.y), bf_lo(hw.z), bf_hi(hw.z), bf_lo(hw.w), bf_hi(hw.w)};
                const float pp[8] = {bf_lo(pw.x), bf_hi(pw.x), bf_lo(pw.y), bf_hi(pw.y), bf_lo(pw.z), bf_hi(pw.z), bf_lo(pw.w), bf_hi(pw.w)};
                const float gv[8] = {bf_lo(gw.x), bf_hi(gw.x), bf_lo(gw.y), bf_hi(gw.y), bf_lo(gw.z), bf_hi(gw.z), bf_lo(gw.w), bf_hi(gw.w)};
                const float cr[8] = {c0[0], c0[1], c0[2], c0[3], c1[0], c1[1], c1[2], c1[3]};
#pragma unroll
                for (int e = 0; e < 8; ++e) { y[j][e] = (hh[e] + pp[e] * cr[e]) * gv[e]; s += y[j][e] * y[j][e]; } }
            const float rs = __builtin_amdgcn_rsqf(wave_sum(s) * (1.0f / DR) + EPS);
#pragma unroll
            for (int j = 0; j < 4; ++j) { const int c = 8 * lane_ + 512 * j; const f32x4 g0 = *(const f32x4*)(gn + c), g1 = *(const f32x4*)(gn + c + 4);
                v4u wv; wv.x = cvt_pk_bf16(y[j][0] * rs * g0[0], y[j][1] * rs * g0[1]); wv.y = cvt_pk_bf16(y[j][2] * rs * g0[2], y[j][3] * rs * g0[3]);
                wv.z = cvt_pk_bf16(y[j][4] * rs * g1[0], y[j][5] * rs * g1[1]); wv.w = cvt_pk_bf16(y[j][6] * rs * g1[2], y[j][7] * rs * g1[3]);
                *(v4u*)(AO + (size_t)row * D + DR + c) = wv; } }
        __syncthreads(); }
}

__device__ __forceinline__ void p9_s5norm(const Args& a, const Ctx& F) {
    PHASE_IDS
    const float* yg = (const float*)(a.ws + WS_AX); const u64* ss = (const u64*)((const unsigned*)(a.ws + WS_CTL) + CW_SS) + 3 * MP; bf16* AO = (bf16*)(a.ws + WS_AX2);
    const int gw = F.vcu * NWAVES + F.wave, NGW = F.G * NWAVES;
    for (int m = gw; m < MX; m += NGW) { const float rs = __builtin_amdgcn_rsqf(ss_get(ss + m) * (1.0f / DS) + EPS);
#pragma unroll
        for (int j = 0; j < 8; ++j) { const int c = 4 * lane_ + 256 * j; const f32x4 o = *(const f32x4*)(yg + (size_t)m * DS + c) * rs;
            v2u wv; wv.x = cvt_pk_bf16(o[0], o[1]); wv.y = cvt_pk_bf16(o[2], o[3]); *(v2u*)(AO + (size_t)m * D + DR + c) = wv; } }
}

__device__ __forceinline__ void p13_final(const Args& a, const Ctx& F) {
    PHASE_IDS
    const u64* ss = (const u64*)((const unsigned*)(a.ws + WS_CTL) + CW_SS) + 2 * MP; const bf16* T = (const bf16*)(a.ws + WS_H);
    const int gw = F.vcu * NWAVES + F.wave, NGW = F.G * NWAVES;
    for (int m = gw; m < MX; m += NGW) { const float rs = __builtin_amdgcn_rsqf(ss_get(ss + m) * (1.0f / D) + EPS);
        v4u w[8];
#pragma unroll
        for (int j = 0; j < 8; ++j) w[j] = *(const v4u*)(T + (size_t)m * D + 8 * lane_ + 512 * j);
#pragma unroll
        for (int j = 0; j < 8; ++j) { float* p = a.out + (size_t)m * D + 8 * lane_ + 512 * j;
            *(f32x4*)p = (f32x4){bf_lo(w[j].x) * rs, bf_hi(w[j].x) * rs, bf_lo(w[j].y) * rs, bf_hi(w[j].y) * rs}; *(f32x4*)(p + 4) = (f32x4){bf_lo(w[j].z) * rs, bf_hi(w[j].z) * rs, bf_lo(w[j].w) * rs, bf_hi(w[j].w) * rs}; } }
}

__device__ __forceinline__ f32x4 skinny_tile(const bf16* A, int lda, const bf16* Bt, int ldb, int ksteps, int wave, int lane, LAS float* red) {
    typedef short bf16x8 __attribute__((ext_vector_type(8)));
    const int fr = lane & 15, fq = lane >> 4;
    const bf16* ap = A + (size_t)fr * lda + (size_t)wave * ksteps * 32 + 8 * fq;
    const bf16* bp = Bt + (size_t)fr * ldb + (size_t)wave * ksteps * 32 + 8 * fq;
    f32x4 acc = {0.f, 0.f, 0.f, 0.f};
    int s0 = 0;
    for (; s0 + 8 <= ksteps; s0 += 8) { bf16x8 av[8], bv[8];
#pragma unroll
        for (int j = 0; j < 8; ++j) { av[j] = *(const bf16x8*)(ap + 32 * (s0 + j)); bv[j] = *(const bf16x8*)(bp + 32 * (s0 + j)); }
#pragma unroll
        for (int j = 0; j < 8; ++j) acc = __builtin_amdgcn_mfma_f32_16x16x32_bf16(bv[j], av[j], acc, 0, 0, 0); }
    for (; s0 < ksteps; ++s0) { const bf16x8 av = *(const bf16x8*)(ap + 32 * s0), bv = *(const bf16x8*)(bp + 32 * s0); acc = __builtin_amdgcn_mfma_f32_16x16x32_bf16(bv, av, acc, 0, 0, 0); }
    *(LAS f32x4*)(red + (wave * 64 + lane) * 4) = acc;
    __syncthreads();
    f32x4 r = {0.f, 0.f, 0.f, 0.f};
    if (wave == 0) {
#pragma unroll
        for (int w = 0; w < 8; ++w) r += *(const LAS f32x4*)(red + (w * 64 + lane) * 4); }
    __syncthreads();
    return r;
}
__device__ __forceinline__ void skinny_g2_meta(const Args& a, const Ctx& F) {
    PHASE_IDS
    const bf16* Hm = (const bf16*)(a.ws + WS_H) + (size_t)MX * FF; const bf16* Wd = (const bf16*)(a.ws + WS_W1D);
    const float* h0 = (const float*)(a.ws + WS_H0M); bf16* HB = (bf16*)(a.ws + WS_HB); u64* ss = (u64*)((unsigned*)(a.ws + WS_CTL) + CW_SS);
    for (int nb = F.vcu; nb < D / 16; nb += F.G) { const int n0 = nb * 16;
        const f32x4 c = skinny_tile(Hm, FF, Wd + (size_t)n0 * FF, FF, FF / 32 / 8, F.wave, lane_, (LAS float*)F.lds);
        if (F.wave == 0) { const int fr = lane_ & 15, col = n0 + 4 * (lane_ >> 4);
            const f32x4 v = *(const f32x4*)(h0 + (size_t)fr * D + col) + c;
            v2u o; o.x = cvt_pk_bf16(v[0], v[1]); o.y = cvt_pk_bf16(v[2], v[3]); *(v2u*)(HB + (size_t)(MX + fr) * D + col) = o;
            float q = (v[0] * v[0] + v[1] * v[1]) + (v[2] * v[2] + v[3] * v[3]); q += __shfl_xor(q, 16); q += __shfl_xor(q, 32);
            if (lane_ < 16) ss_add(ss + MX + fr, q); } }
}
__device__ __forceinline__ void skinny_win_meta(const Args& a, const Ctx& F) {
    PHASE_IDS
    const bf16* Am = (const bf16*)(a.ws + WS_HB) + (size_t)MX * D; const bf16* Wi = (const bf16*)(a.ws + WS_WIN);
    const u64* ss = (const u64*)((const unsigned*)(a.ws + WS_CTL) + CW_SS); bf16* urg = (bf16*)((char*)a.out + DO_URG); bf16* U = (bf16*)(a.ws + WS_U);
    for (int nb = F.vcu; nb < 256; nb += F.G) { const int n0 = (nb < 128) ? nb * 16 : 4096 + (nb - 128) * 16;
        const f32x4 c = skinny_tile(Am, D, Wi + (size_t)n0 * D, D, D / 32 / 8, F.wave, lane_, (LAS float*)F.lds);
        if (F.wave == 0) { const int fr = lane_ & 15, c4 = 4 * (lane_ >> 4);
            const f32x4 v = c * __builtin_amdgcn_rsqf(ss_get(ss + MX + fr) * (1.0f / D) + EPS);
            v2u o; o.x = cvt_pk_bf16(v[0], v[1]); o.y = cvt_pk_bf16(v[2], v[3]);
            if (nb < 128) *(v2u*)(urg + (size_t)(MX + fr) * DR + n0 + c4) = o;
            else *(v2u*)(U + ((size_t)(nb - 128) * NCHP + NCHX) * UK + fr * 16 + c4) = o; } }
}


__device__ __forceinline__ void skinny_gates_meta(const Args& a, const Ctx& F) {
    PHASE_IDS
    const bf16* xcb = (const bf16*)(a.ws + WS_XCB) + (size_t)MX * DR; const bf16* Wrg = (const bf16*)(a.ws + WS_WRG); const float* c8t = (const float*)(a.ws + WS_C8);
    bf16* LA = (bf16*)(a.out + DO_UA / 4); bf16* BX = (bf16*)(a.ws + WS_AX);
    for (int nb = F.vcu; nb < DR / 16; nb += F.G) { const int ch0 = nb * 16, h = ch0 >> 8, hf = (ch0 >> 7) & 1, j0 = ch0 & 127;
        const bf16* Wa = Wrg + (size_t)((h * 2 + hf) * 256 + j0) * 256;
        const f32x4 ta = skinny_tile(xcb + h * 256, DR, Wa, 256, 1, F.wave, lane_, (LAS float*)F.lds);
        const f32x4 tx = skinny_tile(xcb + h * 256, DR, Wa + 128 * 256, 256, 1, F.wave, lane_, (LAS float*)F.lds);
        if (F.wave == 0) { const int fr = lane_ & 15, c = ch0 + 4 * (lane_ >> 4);
            const f32x4 ba = *(const f32x4*)(a.in[I_BA] + c), bx = *(const f32x4*)(a.in[I_BX] + c), c8 = *(const f32x4*)(c8t + c);
            const v2u xw = *(const v2u*)(xcb + (size_t)fr * DR + c); const f32x4 xv = {bf_lo(xw.x), bf_hi(xw.x), bf_lo(xw.y), bf_hi(xw.y)};
            f32x4 l;
#pragma unroll
            for (int e = 0; e < 4; ++e) l[e] = c8[e] * fsigmoid(ta[e] + ba[e]);
            v2u lw; lw.x = cvt_pk_bf16(l[0], l[1]); lw.y = cvt_pk_bf16(l[2], l[3]);
            const f32x4 r = {bf_lo(lw.x), bf_hi(lw.x), bf_lo(lw.y), bf_hi(lw.y)}; f32x4 o;
#pragma unroll
            for (int e = 0; e < 4; ++e) o[e] = __builtin_amdgcn_sqrtf(one_minus_exp(2.0f * r[e])) * fsigmoid(tx[e] + bx[e]) * xv[e];
            v2u ow; ow.x = cvt_pk_bf16(o[0], o[1]); ow.y = cvt_pk_bf16(o[2], o[3]);
            *(v2u*)(LA + (size_t)(MX + fr) * DR + c) = lw; *(v2u*)(BX + (size_t)(MX + fr) * DR + c) = ow; } }
}

__global__ void __launch_bounds__(NTHR, 2) hymba_fwd(Args a) {
    extern __shared__ __attribute__((aligned(16))) unsigned char lds_raw[];
    Ctx F; F.lds = (LAS unsigned char*)lds_raw; F.wave = __builtin_amdgcn_readfirstlane((int)threadIdx.x >> 6);
    F.G = gridDim.x; { const int bx = blockIdx.x; F.vcu = (F.G % 8 == 0) ? (bx % 8) * (F.G / 8) + bx / 8 : bx; }
    volatile LAS unsigned* MISC = (volatile LAS unsigned*)(F.lds + MISC_OFF);
    for (int u = threadIdx.x; u < (LDS_BYTES - RING_BYTES) / 4; u += NTHR) ((LAS unsigned*)(F.lds + RING_BYTES))[u] = 0u;
    __syncthreads();
    unsigned* ctl = (unsigned*)(a.ws + WS_CTL);
    XcdBarrier bar; bar.bar = ctl + CW_BAR; bar.x = 0; bar.st = nullptr;
    if (MK_N_LAUNCHES == 1) bar = xcd_barrier_post(ctl + CW_BAR, MISC + 8);
    const int lo = a.ph_lo, hi = a.ph_hi;
#define IN(k) (lo <= (k) && (k) < hi)
#define SEAM(k) do { if (IN(k) && IN((k) + 1)) xcd_barrier(bar); if (PROBE_SPIN >= 0 && blockIdx.x == 0 && threadIdx.x == 0) { ((unsigned long long*)(ctl + 3000))[(k) + 1] = wall_clock64(); ((unsigned long long*)(ctl + 3000))[100 + (k) + 1] = clock64(); } } while (0)
    u64* ssb = (u64*)(ctl + CW_SS);
    bf16* AX = (bf16*)(a.ws + WS_AX); bf16* HH = (bf16*)(a.ws + WS_H); bf16* HB = (bf16*)(a.ws + WS_HB);
    const int me = (int)blockIdx.x;

    if (PROBE_SPIN >= 0 && blockIdx.x == 0 && threadIdx.x == 0) ((unsigned long long*)(ctl + 3000))[0] = wall_clock64();
    if (IN(0)) { p0_prologue(a, F); if (PROBE_DUP == 0) { __syncthreads(); p0_prologue(a, F); } } SEAM(0);
    if (IN(1)) { p1_quant_w1(a, F); } SEAM(1);
    if (IN(2)) {
        pg8::Gemm g{(const bf16*)(a.ws + WS_AX), (const bf16*)(a.ws + WS_W1GU), D / 2, D / 2, D / 2, 0, 0u}; pg8::StaticOrder S; S.init(NPP, 2 * FF / 256, F.G, me, 16, 16);
        EpiSwigluI8<false> E{HH, (const float*)(a.ws + WS_SW + 131072), nullptr, (const float*)(a.ws + WS_SW), nullptr};
        pg8::gemm_phase<EpiSwigluI8<false>, true, true, false, (PROBE_SPIN >= 30 && PROBE_GP == 2), true>(F.lds, F.wave, g, S, E, nullptr, 0.f, 0.f, (unsigned long long*)(ctl + 3000) + 30); } SEAM(2);
    if (IN(3)) {
        skinny_g2_meta(a, F);
        pg8::Gemm g{HH, (const bf16*)(a.ws + WS_W1D), FF, FF, FF, 0, 0u}; pg8::StaticOrder S; S.init(NPX, D / 256, F.G, me, 16, 16, 0);
        EpiResidB<true, false> E{a.in[I_X], HB, nullptr, ssb};
        pg8::gemm_phase<EpiResidB<true, false>, true, true>(F.lds, F.wave, g, S, E); } SEAM(3);
    if (IN(4)) {
        skinny_win_meta(a, F);
        pg8::Gemm g{HB, (const bf16*)(a.ws + WS_WIN), D, D, D, 0, 0u}; pg8::StaticOrder S; S.init(NPX, 6144 / 256, F.G, me, 32, 8);
        EpiWin E{ssb, (bf16*)((char*)a.out + DO_URG), (bf16*)(a.ws + WS_GG), (bf16*)(a.ws + WS_U)};
        pg8::gemm_phase<EpiWin, true, true>(F.lds, F.wave, g, S, E);
        if (PROBE_DUP == 3) pg8::gemm_phase<EpiWin, true, true>(F.lds, F.wave, g, S, E); } SEAM(4);
    if (IN(5)) { p4_conv(a, F); if (PROBE_DUP == 4) { __syncthreads(); p4_conv(a, F); } } SEAM(5);
    if (IN(6)) {
        skinny_gates_meta(a, F);
        { pg8::Gemm g{(const bf16*)(a.ws + WS_XCB), (const bf16*)(a.ws + WS_WRG), DR, 256, 256, 1, 512u}; pg8::StaticOrder S; S.init(NPX, 16, F.G, me);
          EpiGatesL E{a.in[I_BA], a.in[I_BX], (const float*)(a.ws + WS_C8), (const bf16*)(a.ws + WS_XCB), F.lds};
          for (int i = 0; ; ++i) { pg8::Unit u; if (!S.next(i, u)) break; pg8::StaticOrder S1 = S; S1.single = i * F.G + me;
              pg8::gemm_phase<EpiGatesL, true, true>(F.lds, F.wave, g, S1, E);
              rg_scan_lds(a, F.lds, u.pm, u.pn, F.wave * 64 + pg8::lane_id_opaque()); } }
        { pg8::StaticOrder S; S.init(4, NG, F.G, me);
          for (int i = 0; ; ++i) { pg8::Unit u; if (!S.next(i, u)) break;
            pg8::StaticOrder S1 = S; S1.single = i * F.G + me;
            { pg8::Gemm g{(const bf16*)(a.ws + WS_U), (const bf16*)(a.ws + WS_S5P), UK, 256, 256, 0, (unsigned)(NCHP * UK * 2)};
              EpiS5EL E{(LAS float*)F.lds};
              pg8::gemm_phase<EpiS5EL, true, true>(F.lds, F.wave, g, S1, E); }
            s5_carry_lds(a, u.pm, u.pn, pg8::lane_id_opaque(), F.wave, (const LAS float*)F.lds, (LAS f32x2*)(F.lds + RING_BYTES + 4096)); }
          { VM_WAIT(); __syncthreads(); __builtin_amdgcn_fence(__ATOMIC_ACQUIRE, "agent"); VM_WAIT(); __syncthreads(); }
          { pg8::Gemm g{(const bf16*)(a.ws + WS_U), (const bf16*)(a.ws + WS_S5TQ), UK, UK, UK, 0, (unsigned)(NCHP * UK * 2)};
            EpiS5Y E{(bf16*)(a.ws + WS_Z)};
            pg8::gemm_phase<EpiS5Y, true, true>(F.lds, F.wave, g, S, E); } } } SEAM(6);
    if (IN(7)) {
        pg8::Gemm g{(const bf16*)(a.ws + WS_Z), (const bf16*)(a.ws + WS_WGLU), DS, DS, DS, 0, 0u}; pg8::StaticOrder S; S.init(NPX, DS / 256, F.G, me, 32, 8);
        EpiGlu E{(const bf16*)(a.ws + WS_Z), a.in[I_GLUB], a.in[I_NS5], (bf16*)(a.ws + WS_AX2), ssb + 3 * MP};
        pg8::gemm_phase<EpiGlu, true, true>(F.lds, F.wave, g, S, E); p7_colmax_w2(a, F); } SEAM(7);
    if (IN(8)) { p8_quant_w2(a, F); p7_rgfix(a, F); } SEAM(8);
    if (IN(9)) {
        pg8::Gemm g{(const bf16*)(a.ws + WS_AX2), (const bf16*)(a.ws + WS_WOUT), D, D, D, 0, 0u}; pg8::StaticOrder S; S.init(NPX, D / 256, F.G, me, 16, 16);
        EpiResidB<false, false> E{HB, HB, nullptr, ssb + MP};
        pg8::gemm_phase<EpiResidB<false, false>, true, true, true, (PROBE_SPIN >= 30 && PROBE_GP == 9)>(F.lds, F.wave, g, S, E, ssb + 3 * MP, 1.0f / DS, EPS, (unsigned long long*)(ctl + 3000) + 30); } SEAM(9);
    if (IN(10)) { p10_quant_h2(a, F); } SEAM(10);
    if (IN(11)) {
        pg8::Gemm g{(const bf16*)(a.ws + WS_AX), (const bf16*)(a.ws + WS_W1GU), D / 2, D / 2, D / 2, 0, 0u}; pg8::StaticOrder S; S.init(NPX, 2 * FF / 256, F.G, me, 16, 16);
        EpiSwigluI8<false> E{HH, (const float*)(a.ws + WS_SW + 131072), nullptr, (const float*)(a.ws + WS_SW), nullptr};
        pg8::gemm_phase<EpiSwigluI8<false>, true, true, false, (PROBE_SPIN >= 30 && PROBE_GP == 11), true>(F.lds, F.wave, g, S, E, nullptr, 0.f, 0.f, (unsigned long long*)(ctl + 3000) + 30);
        { const int rem = (NPX * (2 * FF / 256)) % F.G;
          if (rem == 0) p11_quant_wd(a, F, F.vcu, F.G); else if (me >= rem) p11_quant_wd(a, F, me - rem, F.G - rem); } } SEAM(11);
    if (IN(12)) { p12_quant_h(a, F); } SEAM(12);
    if (IN(13)) {
        pg8::Gemm g{(const bf16*)(a.ws + WS_AX), (const bf16*)(a.ws + WS_W1D), FF / 2, FF / 2, FF / 2, 0, 0u}; pg8::StaticOrder S; S.init(NPX, D / 256, F.G, me, 16, 16);
        EpiResidI8 E{HB, HH, a.in[I_NFIN], ssb + 2 * MP, (const float*)(a.ws + WS_SW + 393216), (const float*)(a.ws + WS_SW + 262144)};
        pg8::gemm_phase<EpiResidI8, true, true, false, false, true>(F.lds, F.wave, g, S, E); } SEAM(13);
    if (IN(14)) { p13_final(a, F); }
    if (PROBE_SPIN >= 0 && blockIdx.x == PROBE_BLK && threadIdx.x == 0) { VM_WAIT(); const unsigned long long t1 = wall_clock64(); const unsigned long long* ts = (const unsigned long long*)(ctl + 3000);
        unsigned long long dt = (PROBE_SPIN >= 30) ? (ts[PROBE_B] - ts[PROBE_A]) : (((PROBE_SPIN == N_PHASES - 1) ? t1 : ts[PROBE_SPIN + 1]) - ts[PROBE_SPIN]);
        if (PROBE_SPIN >= 100) { const int p = PROBE_SPIN - 100; dt = (ts[100 + p + 1] - ts[100 + p]) * 10000ull / (ts[p + 1] - ts[p]); }
        const unsigned long long until = t1 + (unsigned long long)(PROBE_SPIN >= 100 ? 1 : (PROBE_SPIN >= 30 ? PROBE_MUL : 10)) * dt;
        while (wall_clock64() < until) __builtin_amdgcn_s_sleep(16); }
#undef IN
#undef SEAM
}

extern "C" void kernel_launch(void* const* d_in, const int* in_sizes, int n_in, void* d_out, int out_size, void* d_ws, size_t ws_size, hipStream_t stream) {
    static int grid = 0;
    if (grid == 0) {
        if (n_in != 33 || in_sizes[0] != MX * D || out_size != MX * D || ws_size < WS_END) { fprintf(stderr, "kernel_launch: shape/workspace mismatch (n_in %d, ws %zu < %zu)\n", n_in, ws_size, (size_t)WS_END); grid = -1; return; }
        int dev = 0, cus = 0, per_cu = 0;
        if (hipGetDevice(&dev) != hipSuccess || hipDeviceGetAttribute(&cus, hipDeviceAttributeMultiprocessorCount, dev) != hipSuccess) { grid = -1; return; }
        if (hipFuncSetAttribute((const void*)hymba_fwd, hipFuncAttributeMaxDynamicSharedMemorySize, LDS_BYTES) != hipSuccess) { fprintf(stderr, "kernel_launch: hipFuncSetAttribute failed\n"); grid = -1; return; }
        if (hipOccupancyMaxActiveBlocksPerMultiprocessor(&per_cu, (const void*)hymba_fwd, NTHR, LDS_BYTES) != hipSuccess || per_cu < 1) fprintf(stderr, "kernel_launch: occupancy query says %d\n", per_cu);
        (void)hipGetLastError();
        grid = cus;
    }
    if (grid < 0) return;
    if (hipMemsetAsync((char*)d_ws + WS_CTL, 0, CTL_ZERO_BYTES, stream) != hipSuccess) return;
    Args a{};
    for (int i = 0; i < 33; ++i) a.in[i] = (const float*)d_in[i];
    a.out = (float*)d_out; a.ws = (unsigned char*)d_ws;
    if (MK_N_LAUNCHES == 1) { a.ph_lo = 0; a.ph_hi = N_PHASES; hipLaunchKernelGGL(hymba_fwd, dim3(grid), dim3(NTHR), LDS_BYTES, stream, a); }
    else for (int p = 0; p < N_PHASES; ++p) { a.ph_lo = p; a.ph_hi = p + 1; hipLaunchKernelGGL(hymba_fwd, dim3(grid), dim3(NTHR), LDS_BYTES, stream, a); }
    const hipError_t le = hipPeekAtLastError();
    if (le != hipSuccess) fprintf(stderr, "kernel_launch: launch failed: %s\n", hipGetErrorName(le));
}
```
